# Optimizing an MI355X kernel written in HIP

```python
import math
import jax, jax.numpy as jnp
from jax import lax
import numpy as np

D_MODEL = 1024
BATCH = 4
SEQ = 4096
DEPTH = 1

N_MEM = 256
MEM_HEADS = 4
MEM_HEAD_DIM = D_MODEL // MEM_HEADS
HEAD_DIM = 64
SWA_HEADS = D_MODEL // HEAD_DIM
SWA_KV_HEADS = 4
WINDOW = 128
BLOCK = 128
REL_BUCKETS = 32
REL_MAX_DIST = 128
CONV_WIDTH = D_MODEL
CONV_K = 3
D_FF = 2816
EPS = 1e-6
NEG_INF = -1e30
POS_PAD = 1 << 30

Q_WIDTH = SWA_HEADS * HEAD_DIM
KV_WIDTH = SWA_KV_HEADS * HEAD_DIM
IN_WIDTHS = (Q_WIDTH, KV_WIDTH, KV_WIDTH, CONV_WIDTH, CONV_WIDTH, CONV_WIDTH, D_MODEL, D_MODEL)
IN_WIDTH = Q_WIDTH + 2 * KV_WIDTH + 3 * CONV_WIDTH + 2 * D_MODEL

kernel_name = "hybrid_gated_swa_shortconv_macaron"


def rms_norm(x, g):
    xf = x.astype(jnp.float32)
    y = xf * lax.rsqrt(jnp.mean(xf * xf, axis=-1, keepdims=True) + EPS)
    return (y * g.astype(jnp.float32)).astype(x.dtype)


def swiglu_ffn(h, w_gu, w_down):
    gate, up = jnp.split(h @ w_gu, 2, axis=-1)
    return (jax.nn.silu(gate) * up) @ w_down


def split_cols(t, widths):
    outs, start = [], 0
    for w in widths:
        outs.append(t[..., start:start + w])
        start += w
    return outs


def t5_causal_bucket(rel):
    n = jnp.maximum(rel, 0)
    max_exact = REL_BUCKETS // 2
    nf = jnp.maximum(n, 1).astype(jnp.float32)
    large = max_exact + (jnp.log(nf / max_exact) / math.log(REL_MAX_DIST / max_exact)
                         * (REL_BUCKETS - max_exact)).astype(jnp.int32)
    large = jnp.minimum(large, REL_BUCKETS - 1)
    return jnp.where(n < max_exact, n, large)


def with_prev_block(t, fill):
    b, s = t.shape[0], t.shape[1]
    nb = s // BLOCK
    tb = t.reshape((b, nb, BLOCK) + t.shape[2:])
    pad = jnp.full_like(tb[:, :1], fill)
    prev = jnp.concatenate([pad, tb[:, :-1]], axis=1)
    return jnp.concatenate([prev, tb], axis=2)


def sliding_window_gqa(q, k, v, positions, rel_bias, sinks):
    b, s, _ = q.shape
    nb = s // BLOCK
    grp = SWA_HEADS // SWA_KV_HEADS
    qb = q.reshape(b, nb, BLOCK, SWA_KV_HEADS, grp, HEAD_DIM)
    kb = with_prev_block(k.reshape(b, s, SWA_KV_HEADS, HEAD_DIM), 0)
    vb = with_prev_block(v.reshape(b, s, SWA_KV_HEADS, HEAD_DIM), 0)
    pq = positions.reshape(b, nb, BLOCK)
    pk = with_prev_block(positions, POS_PAD)
    rel = pq[:, :, :, None] - pk[:, :, None, :]
    visible = (rel >= 0) & (rel < WINDOW)
    bias = jnp.moveaxis(rel_bias[t5_causal_bucket(rel)], -1, 2)
    bias = bias.reshape(b, nb, SWA_KV_HEADS, grp, BLOCK, 2 * BLOCK).astype(jnp.float32)
    logits = jnp.einsum('bnqhgd,bnkhd->bnhgqk', qb, kb).astype(jnp.float32) * (HEAD_DIM ** -0.5)
    logits = jnp.where(visible[:, :, None, None], logits + bias, NEG_INF)
    sink = jnp.broadcast_to(sinks.astype(jnp.float32).reshape(1, 1, SWA_KV_HEADS, grp, 1, 1),
                            logits.shape[:-1] + (1,))
    probs = jax.nn.softmax(jnp.concatenate([logits, sink], axis=-1), axis=-1)[..., :-1]
    out = jnp.einsum('bnhgqk,bnkhd->bnqhgd', probs.astype(vb.dtype), vb)
    return out.reshape(b, s, Q_WIDTH)


def short_conv(u, w_conv):
    s = u.shape[1]
    up = jnp.pad(u, ((0, 0), (CONV_K - 1, 0), (0, 0)))
    return sum(w_conv[j] * up[:, j:j + s] for j in range(CONV_K))


def memory_cross_attention(h, mem_h, w_q, w_kv, w_o):
    b, s, _ = h.shape
    m = mem_h.shape[1]
    q = (h @ w_q).reshape(b, s, MEM_HEADS, MEM_HEAD_DIM)
    k, v = jnp.split(mem_h @ w_kv, 2, axis=-1)
    k = k.reshape(b, m, MEM_HEADS, MEM_HEAD_DIM)
    v = v.reshape(b, m, MEM_HEADS, MEM_HEAD_DIM)
    logits = jnp.einsum('bshd,bmhd->bhsm', q, k).astype(jnp.float32) * (MEM_HEAD_DIM ** -0.5)
    probs = jax.nn.softmax(logits, axis=-1)
    o = jnp.einsum('bhsm,bmhd->bshd', probs.astype(v.dtype), v).reshape(b, s, D_MODEL)
    return o @ w_o


def setup_inputs(seed: int = 0) -> dict:
    key = jax.random.key(seed)
    ks = jax.random.split(key, 24)
    f32 = jnp.float32

    def dense(k, shape, fan_in):
        return jax.random.normal(k, shape, f32) * (fan_in ** -0.5)

    def gain(k, shape):
        return 1.0 + 0.05 * jax.random.normal(k, shape, f32)

    L = DEPTH
    x = jax.random.normal(ks[0], (BATCH, SEQ, D_MODEL), f32)
    mem = jax.random.normal(ks[1], (BATCH, N_MEM, D_MODEL), f32)
    offsets = jax.random.randint(ks[2], (BATCH, 1), 0, 1024, dtype=jnp.int32)
    positions = offsets + jnp.arange(SEQ, dtype=jnp.int32)[None, :]
    return {
        "x": x,
        "mem": mem,
        "positions": positions,
        "rel_bias": 0.5 * jax.random.normal(ks[3], (REL_BUCKETS, SWA_HEADS), f32),
        "ffn1_norm": gain(ks[4], (L, D_MODEL)),
        "ffn1_w_gu": dense(ks[5], (L, D_MODEL, 2 * D_FF), D_MODEL),
        "ffn1_w_down": dense(ks[6], (L, D_FF, D_MODEL), D_FF),
        "mix_norm": gain(ks[7], (L, D_MODEL)),
        "w_in": dense(ks[8], (L, D_MODEL, IN_WIDTH), D_MODEL),
        "sinks": 0.5 * jax.random.normal(ks[9], (L, SWA_HEADS), f32),
        "conv_w": dense(ks[10], (L, CONV_K, CONV_WIDTH), CONV_K),
        "w_out": dense(ks[11], (L, D_MODEL, D_MODEL), D_MODEL),
        "xattn_norm": gain(ks[12], (L, D_MODEL)),
        "mem_norm": gain(ks[13], (L, D_MODEL)),
        "xattn_wq": dense(ks[14], (L, D_MODEL, D_MODEL), D_MODEL),
        "xattn_wkv": dense(ks[15], (L, D_MODEL, 2 * D_MODEL), D_MODEL),
        "xattn_wo": dense(ks[16], (L, D_MODEL, D_MODEL), D_MODEL),
        "ffn2_norm": gain(ks[17], (L, D_MODEL)),
        "ffn2_w_gu": dense(ks[18], (L, D_MODEL, 2 * D_FF), D_MODEL),
        "ffn2_w_down": dense(ks[19], (L, D_FF, D_MODEL), D_FF),
        "final_norm": gain(ks[20], (D_MODEL,)),
    }


def reference(x, mem, positions, rel_bias, ffn1_norm, ffn1_w_gu, ffn1_w_down, mix_norm, w_in,
              sinks, conv_w, w_out, xattn_norm, mem_norm, xattn_wq, xattn_wkv, xattn_wo,
              ffn2_norm, ffn2_w_gu, ffn2_w_down, final_norm):
    for l in range(DEPTH):
        x = x + 0.5 * swiglu_ffn(rms_norm(x, ffn1_norm[l]), ffn1_w_gu[l], ffn1_w_down[l])
        h = rms_norm(x, mix_norm[l])
        q, k, v, c_pre, b_post, u, g_attn, g_conv = split_cols(h @ w_in[l], IN_WIDTHS)
        attn = sliding_window_gqa(q, k, v, positions, rel_bias, sinks[l])
        conv = b_post * short_conv(c_pre * u, conv_w[l])
        merged = jax.nn.sigmoid(g_attn) * attn + jax.nn.sigmoid(g_conv) * conv
        x = x + merged @ w_out[l]
        x = x + memory_cross_attention(rms_norm(x, xattn_norm[l]), rms_norm(mem, mem_norm[l]),
                                       xattn_wq[l], xattn_wkv[l], xattn_wo[l])
        x = x + 0.5 * swiglu_ffn(rms_norm(x, ffn2_norm[l]), ffn2_w_gu[l], ffn2_w_down[l])
    return rms_norm(x, final_norm)
```

```cpp
#include <hip/hip_runtime.h>
#include <hip/hip_bf16.h>
#include <cstdio>
#include <cstdint>
#include <cmath>
namespace pg8 {
#define PG8_LAS __attribute__((address_space(3)))
typedef unsigned short bf16_t;
typedef short bf16x8 __attribute__((ext_vector_type(8)));
typedef float f32x4 __attribute__((ext_vector_type(4)));
typedef unsigned u32x4 __attribute__((ext_vector_type(4)));
constexpr int BM = 256, BK = 64, HALF = 128, HTB = HALF * BK * 2  , STAGE_BYTES = 8 * HTB, NXCD = 8, WGM = 8;

__host__ __device__ __forceinline__ int lds_byte(int r, int c) { const int st = (r >> 4) * 2 + (c >> 5), rr = r & 15, cc = c & 31, ob = rr * 64 + cc * 2; return st * 1024 + (ob ^ (((ob >> 9) & 1) << 5)); }
__host__ __device__ __forceinline__ void stage_rc(int b, int& R, int& C) { const int st = b / 1024, sb = b % 1024, swz = sb ^ (((sb >> 9) & 1) << 5); R = (st >> 1) * 16 + swz / 64; C = (st & 1) * 32 + (swz % 64) / 2; }
__host__ __device__ __forceinline__ int perm32(int rho) { const int n = rho >> 4, i = rho & 15; return 8 * (i >> 2) + 4 * n + (i & 3); }

struct Unit { int pm, pn; };
struct Gemm { const bf16_t* A; const bf16_t* Bt; int M, N, K; };

struct StaticOrder {
    int nM, nN, nwg, G, c;
    __host__ __device__ void init(int M, int N, int G_, int c_) { nM = M / BM; nN = N / BM; nwg = nM * nN; G = G_; c = c_; }
    __host__ __device__ bool next(int i, Unit& u) const {
        const long L = (long)i * G + c; if (L >= nwg) return false;
        int wgid = (int)L; { const int q = nwg / NXCD, r = nwg % NXCD, xcd = wgid % NXCD, off = wgid / NXCD; wgid = (xcd < r ? xcd * (q + 1) : r * (q + 1) + (xcd - r) * q) + off; }
        const int nig = WGM * nN, gid = wgid / nig, fm = gid * WGM, gsz = (nM - fm) < WGM ? (nM - fm) : WGM;
        u.pm = fm + ((wgid % nig) % gsz); u.pn = (wgid % nig) / gsz; return true;
    }
    __device__ __forceinline__ void a_ready(const Unit&) const {}
    __device__ __forceinline__ void done(const Unit&) const {}
};

__device__ __forceinline__ unsigned cvt_pk_bf16(float lo, float hi) { unsigned r; asm volatile("v_cvt_pk_bf16_f32 %0, %1, %2" : "=v"(r) : "v"(lo), "v"(hi)); return r; }
__device__ __forceinline__ float row_rs(const float* ss, int row) {
    const f32x4 p = *(const f32x4*)(ss + (size_t)row * 4);
    return __builtin_amdgcn_rsqf(((p[0] + p[1]) + (p[2] + p[3])) * (1.0f / 1024.0f) + 1e-6f);
}
__device__ __forceinline__ float sigmoidf_(float x) { return __builtin_amdgcn_rcpf(1.0f + __builtin_amdgcn_exp2f(-1.4426950408889634f * x)); }
__device__ __forceinline__ u32x4 pack8(const f32x4 v0, const f32x4 v1) { u32x4 w; w.x = cvt_pk_bf16(v0[0], v0[1]); w.y = cvt_pk_bf16(v0[2], v0[3]); w.z = cvt_pk_bf16(v1[0], v1[1]); w.w = cvt_pk_bf16(v1[2], v1[3]); return w; }

struct EpiRowBf16 {
    static constexpr bool PERM = true, AFTER_DRAIN = false;
    bf16_t* O; int ldc; const float* ss; float scale;
    __device__ __forceinline__ void operator()(const f32x4 (&acc)[2][2][4][2], const Unit& u, int wr, int wc, int fr, int fq) const {
        const int row0 = u.pm * BM + wr * 64 + fr, col0 = u.pn * BM + wc * 32 + 8 * fq;
#pragma unroll
        for (int ai = 0; ai < 2; ++ai)
#pragma unroll
            for (int m = 0; m < 4; ++m) { const int row = row0 + ai * HALF + m * 16; const float r = ss ? row_rs(ss, row) * scale : scale; bf16_t* rowp = O + (size_t)row * ldc + col0;
#pragma unroll
                for (int bj = 0; bj < 2; ++bj) *(u32x4*)(rowp + bj * HALF) = pack8(acc[ai][bj][m][0] * r, acc[ai][bj][m][1] * r); }
    }
};
struct EpiSwiglu {
    static constexpr bool PERM = true, AFTER_DRAIN = false;
    bf16_t* H; int ldh; const float* ss;
    __device__ __forceinline__ void operator()(const f32x4 (&acc)[2][2][4][2], const Unit& u, int wr, int wc, int fr, int fq) const {
        const int row0 = u.pm * BM + wr * 64 + fr, col0 = u.pn * HALF + wc * 32 + 8 * fq;
#pragma unroll
        for (int ai = 0; ai < 2; ++ai)
#pragma unroll
            for (int m = 0; m < 4; ++m) { const int row = row0 + ai * HALF + m * 16; const float r = row_rs(ss, row); f32x4 h[2];
#pragma unroll
                for (int n = 0; n < 2; ++n) { const f32x4 g = acc[ai][0][m][n] * r, up = acc[ai][1][m][n] * r;
#pragma unroll
                    for (int j = 0; j < 4; ++j) h[n][j] = g[j] * up[j] * sigmoidf_(g[j]); }
                *(u32x4*)(H + (size_t)row * ldh + col0) = pack8(h[0], h[1]); }
    }
};
struct EpiIn {
    static constexpr bool PERM = true, AFTER_DRAIN = false;
    bf16_t *Q, *K, *V, *CU, *GB, *SA; const float* ss; float qscale;
    __device__ __forceinline__ void operator()(const f32x4 (&acc)[2][2][4][2], const Unit& u, int wr, int wc, int fr, int fq) const {
        const int row0 = u.pm * BM + wr * 64 + fr, cw = wc * 32 + 8 * fq, pn = u.pn;
        if (pn < 6 || pn >= 22) {
            bf16_t* base; int ldc, colt; float sc = 1.f; const bool sig = pn >= 22;
            if (pn < 4) { base = Q; ldc = 1024; colt = pn * 256; sc = qscale; } else if (pn == 4) { base = K; ldc = 256; colt = 0; } else if (pn == 5) { base = V; ldc = 256; colt = 0; } else { base = SA; ldc = 1024; colt = (pn - 22) * 256; }
#pragma unroll
            for (int ai = 0; ai < 2; ++ai)
#pragma unroll
                for (int m = 0; m < 4; ++m) { const int row = row0 + ai * HALF + m * 16; const float r = row_rs(ss, row) * sc; bf16_t* rowp = base + (size_t)row * ldc + colt + cw;
#pragma unroll
                    for (int bj = 0; bj < 2; ++bj) { f32x4 v0 = acc[ai][bj][m][0] * r, v1 = acc[ai][bj][m][1] * r;
                        if (sig) {
#pragma unroll
                            for (int j = 0; j < 4; ++j) { v0[j] = sigmoidf_(v0[j]); v1[j] = sigmoidf_(v1[j]); } }
                        *(u32x4*)(rowp + bj * HALF) = pack8(v0, v1); } }
        } else {
            const bool isgb = pn >= 14; bf16_t* base = isgb ? GB : CU; const int colt = ((pn - 6) & 7) * HALF;
#pragma unroll
            for (int ai = 0; ai < 2; ++ai)
#pragma unroll
                for (int m = 0; m < 4; ++m) { const int row = row0 + ai * HALF + m * 16; const float r = row_rs(ss, row); f32x4 h[2];
#pragma unroll
                    for (int n = 0; n < 2; ++n) { const f32x4 a = acc[ai][0][m][n] * r, b = acc[ai][1][m][n] * r;
#pragma unroll
                        for (int j = 0; j < 4; ++j) h[n][j] = a[j] * (isgb ? sigmoidf_(b[j]) : b[j]); }
                    *(u32x4*)(base + (size_t)row * 1024 + colt + cw) = pack8(h[0], h[1]); }
        }
    }
};
struct EpiRes {
    static constexpr bool PERM = true, AFTER_DRAIN = true;
    const float* base; float* out; bf16_t* xb; float* ssq; float alpha;
    __device__ __forceinline__ void fused(f32x4 (&acc)[2][2][4][2], const Unit& u, int wr, int wc, int fr, int fq, PG8_LAS unsigned char* lds, int wid, int lane) const {
        PG8_LAS float* P = (PG8_LAS float*)lds;
        const int col0 = u.pn * BM + wc * 32 + 8 * fq;
#pragma unroll
        for (int ai = 0; ai < 2; ++ai)
#pragma unroll
            for (int m = 0; m < 4; ++m) { const int rl = ai * HALF + wr * 64 + m * 16 + fr; const size_t off = (size_t)(u.pm * BM + rl) * 1024 + col0; float s = 0.f;
#pragma unroll
                for (int bj = 0; bj < 2; ++bj) { const f32x4 b0 = *(const f32x4*)(base + off + bj * HALF), b1 = *(const f32x4*)(base + off + bj * HALF + 4);
                    const f32x4 v0 = b0 + acc[ai][bj][m][0] * alpha, v1 = b1 + acc[ai][bj][m][1] * alpha;
                    *(f32x4*)(out + off + bj * HALF) = v0; *(f32x4*)(out + off + bj * HALF + 4) = v1; *(u32x4*)(xb + off + bj * HALF) = pack8(v0, v1);
                    s += ((v0[0] * v0[0] + v0[1] * v0[1]) + (v0[2] * v0[2] + v0[3] * v0[3])) + ((v1[0] * v1[0] + v1[1] * v1[1]) + (v1[2] * v1[2] + v1[3] * v1[3])); }
                s += __shfl_xor(s, 16); s += __shfl_xor(s, 32);
                if (fq == 0) P[rl * 4 + wc] = s;
                asm volatile("" ::: "memory"); }
        asm volatile("s_waitcnt lgkmcnt(0)" ::: "memory"); __builtin_amdgcn_s_barrier(); asm volatile("" ::: "memory");
        const int tid = wid * 64 + lane;
        if (tid < 256) { const f32x4 p = *(const PG8_LAS f32x4*)(P + tid * 4); ssq[(size_t)(u.pm * BM + tid) * 4 + u.pn] = (p[0] + p[1]) + (p[2] + p[3]); }
    }
};

template <class Epi, class Sched, bool ALIGN_EPI = false, bool SP2 = false>
__device__ __forceinline__ void gemm_phase(PG8_LAS unsigned char* lds, const Gemm g, const Sched& S, const Epi& E) {
    int tid_ = threadIdx.x; asm volatile("" : "+v"(tid_));
    const int tid = tid_, wid = __builtin_amdgcn_readfirstlane(tid >> 6), lane = tid & 63, wr = wid >> 2, wc = wid & 3, fr = lane & 15, fq = lane >> 4;
    const int K = g.K, nt = K / BK;
    unsigned voffA[2], voffB[2];
#pragma unroll
    for (int i = 0; i < 2; ++i) { int R, C; stage_rc(tid * 16 + i * 8192, R, C); const int Rb = Epi::PERM ? ((R & ~31) + perm32(R & 31)) : R;
        voffA[i] = (unsigned)(R * K + C) * 2u; voffB[i] = (unsigned)(Rb * K + C) * 2u; }
    const size_t kstep = (size_t)(BK * 2);
    const size_t hstep = (size_t)HALF * K * 2;
    const size_t tstep = 2 * hstep;
    const unsigned ldsw = (unsigned)wid * 1024u;
    const int aoff = lds_byte(wr * 64 + fr, fq * 8), boff = lds_byte(wc * 32 + fr, fq * 8);
#define PG8_SA(b, h) (((b) * 2 + (h)) * HTB)
#define PG8_SB(b, h) ((4 + (b) * 2 + (h)) * HTB)
#define PG8_STAGE(bufoff, gbase, voff) do { _Pragma("unroll") for (int _i = 0; _i < 2; ++_i) \
        __builtin_amdgcn_global_load_lds((const unsigned*)((const char*)(gbase) + (voff)[_i]), (PG8_LAS unsigned*)(lds + (bufoff) + ldsw + _i * 8192), 16, 0, 0); } while (0)
#define PG8_LDA(dst, b, h) do { _Pragma("unroll") for (int m = 0; m < 4; ++m) _Pragma("unroll") for (int k = 0; k < 2; ++k) dst[m][k] = *(const PG8_LAS bf16x8*)(lds + PG8_SA(b, h) + aoff + m * 2048 + k * 1024); } while (0)
#define PG8_LDB(dst, b, h) do { _Pragma("unroll") for (int n = 0; n < 2; ++n) _Pragma("unroll") for (int k = 0; k < 2; ++k) dst[n][k] = *(const PG8_LAS bf16x8*)(lds + PG8_SB(b, h) + boff + n * 2048 + k * 1024); } while (0)
#define PG8_MMA(ai, bj, At, Bt) do { __builtin_amdgcn_s_setprio(1); _Pragma("unroll") for (int m = 0; m < 4; ++m) _Pragma("unroll") for (int n = 0; n < 2; ++n) _Pragma("unroll") for (int k = 0; k < 2; ++k) \
        acc[ai][bj][m][n] = __builtin_amdgcn_mfma_f32_16x16x32_bf16(Bt[n][k], At[m][k], acc[ai][bj][m][n], 0, 0, 0); __builtin_amdgcn_s_setprio(0); } while (0)
#define PG8_WAIT_V(n) asm volatile("s_waitcnt vmcnt(" #n ")" ::: "memory")
#define PG8_WAIT_L(n) asm volatile("s_waitcnt lgkmcnt(" #n ")" ::: "memory")
#define PG8_BAR __builtin_amdgcn_s_barrier()
#define PG8_SCHED __builtin_amdgcn_sched_barrier(0)
    Unit cur, nxt; int ui = 0;
    if (!S.next(0, cur)) return;
    f32x4 acc[2][2][4][2];
#pragma unroll
    for (int a = 0; a < 2; ++a)
#pragma unroll
        for (int b = 0; b < 2; ++b)
#pragma unroll
            for (int m = 0; m < 4; ++m)
#pragma unroll
                for (int n = 0; n < 2; ++n) acc[a][b][m][n] = (f32x4){0.f, 0.f, 0.f, 0.f};
    bf16x8 At[4][2], B0[2][2], B1[2][2];
    const char* cA = (const char*)g.A + (size_t)cur.pm * tstep; const char* cB = (const char*)g.Bt + (size_t)cur.pn * tstep;
    S.a_ready(cur);
    if constexpr (SP2) {
        PG8_STAGE(PG8_SB(0, 0), cB, voffB); PG8_STAGE(PG8_SB(0, 1), cB + hstep, voffB); PG8_STAGE(PG8_SA(0, 0), cA, voffA); PG8_STAGE(PG8_SA(0, 1), cA + hstep, voffA);
        if (wr == 1) PG8_BAR;
        PG8_WAIT_V(2); PG8_BAR;
        PG8_STAGE(PG8_SB(1, 0), cB + kstep, voffB); PG8_STAGE(PG8_SA(1, 0), cA + kstep, voffA); PG8_STAGE(PG8_SB(1, 1), cB + hstep + kstep, voffB);
        PG8_WAIT_V(6); PG8_BAR;
    } else {
        PG8_STAGE(PG8_SB(0, 0), cB, voffB); PG8_STAGE(PG8_SA(0, 0), cA, voffA); PG8_STAGE(PG8_SB(0, 1), cB + hstep, voffB); PG8_STAGE(PG8_SA(0, 1), cA + hstep, voffA);
        if (wr == 1) PG8_BAR;
        PG8_WAIT_V(4); PG8_BAR;
        PG8_STAGE(PG8_SB(1, 0), cB + kstep, voffB); PG8_STAGE(PG8_SA(1, 0), cA + kstep, voffA); PG8_STAGE(PG8_SB(1, 1), cB + hstep + kstep, voffB);
        PG8_WAIT_V(6); PG8_BAR;
    }
    for (;;) {
        const bool has_next = S.next(ui + 1, nxt);
        const char* nA = has_next ? (const char*)g.A + (size_t)nxt.pm * tstep : cA; const char* nB = has_next ? (const char*)g.Bt + (size_t)nxt.pn * tstep : cB;
        for (int t = 0; t < nt; t += 2) {
            const bool last = (t == nt - 2);
            const char* a1 = cA + (size_t)(t + 1) * kstep;
            const char* a2 = last ? nA : cA + (size_t)(t + 2) * kstep; const char* b2 = last ? nB : cB + (size_t)(t + 2) * kstep;
            const char* a3 = a2 + kstep; const char* b3 = b2 + kstep;
            if (last && has_next) S.a_ready(nxt);
            if constexpr (SP2) {
            PG8_LDB(B0, 0, 0); PG8_LDB(B1, 0, 1); PG8_SCHED; PG8_LDA(At, 0, 0); PG8_STAGE(PG8_SA(1, 1), a1 + hstep, voffA);
            PG8_WAIT_V(8); PG8_WAIT_L(0); PG8_BAR; PG8_MMA(0, 0, At, B0); PG8_MMA(0, 1, At, B1); PG8_BAR; PG8_SCHED;
            PG8_LDA(At, 0, 1); PG8_STAGE(PG8_SB(0, 0), b2, voffB); PG8_STAGE(PG8_SB(0, 1), b2 + hstep, voffB); PG8_STAGE(PG8_SA(0, 0), a2, voffA);
            PG8_WAIT_V(8); PG8_WAIT_L(0); PG8_BAR; PG8_MMA(1, 0, At, B0); PG8_MMA(1, 1, At, B1); PG8_BAR; PG8_SCHED;
            PG8_LDB(B0, 1, 0); PG8_LDB(B1, 1, 1); PG8_SCHED; PG8_LDA(At, 1, 0); PG8_STAGE(PG8_SA(0, 1), a2 + hstep, voffA);
            PG8_WAIT_V(8); PG8_WAIT_L(0); PG8_BAR; PG8_MMA(0, 0, At, B0); PG8_MMA(0, 1, At, B1); PG8_BAR; PG8_SCHED;
            PG8_LDA(At, 1, 1); PG8_STAGE(PG8_SB(1, 0), b3, voffB); PG8_STAGE(PG8_SB(1, 1), b3 + hstep, voffB); PG8_STAGE(PG8_SA(1, 0), a3, voffA);
            PG8_WAIT_V(8); PG8_WAIT_L(0); PG8_BAR; PG8_MMA(1, 0, At, B0); PG8_MMA(1, 1, At, B1); PG8_BAR; PG8_SCHED;
            } else {
            PG8_LDB(B0, 0, 0); PG8_SCHED; PG8_LDA(At, 0, 0); PG8_STAGE(PG8_SA(1, 1), a1 + hstep, voffA);
            PG8_WAIT_L(8); PG8_BAR; PG8_WAIT_L(0); PG8_MMA(0, 0, At, B0); PG8_BAR; PG8_SCHED;
            PG8_LDB(B1, 0, 1); PG8_STAGE(PG8_SB(0, 0), b2, voffB);
            PG8_BAR; PG8_WAIT_L(0); PG8_MMA(0, 1, At, B1); PG8_BAR;
            PG8_LDA(At, 0, 1); PG8_STAGE(PG8_SA(0, 0), a2, voffA);
            PG8_BAR; PG8_WAIT_L(0); PG8_MMA(1, 0, At, B0); PG8_BAR; PG8_SCHED;
            PG8_STAGE(PG8_SB(0, 1), b2 + hstep, voffB);
            PG8_WAIT_V(6); PG8_BAR; PG8_MMA(1, 1, At, B1); PG8_BAR;
            PG8_LDB(B0, 1, 0); PG8_SCHED; PG8_LDA(At, 1, 0); PG8_STAGE(PG8_SA(0, 1), a2 + hstep, voffA);
            PG8_WAIT_L(8); PG8_BAR; PG8_WAIT_L(0); PG8_MMA(0, 0, At, B0); PG8_BAR; PG8_SCHED;
            PG8_LDB(B1, 1, 1); PG8_STAGE(PG8_SB(1, 0), b3, voffB);
            PG8_BAR; PG8_WAIT_L(0); PG8_MMA(0, 1, At, B1); PG8_BAR;
            PG8_LDA(At, 1, 1); PG8_STAGE(PG8_SA(1, 0), a3, voffA);
            PG8_BAR; PG8_WAIT_L(0); PG8_MMA(1, 0, At, B0); PG8_BAR; PG8_SCHED;
            PG8_STAGE(PG8_SB(1, 1), b3 + hstep, voffB);
            PG8_WAIT_V(6); PG8_BAR; PG8_MMA(1, 1, At, B1); PG8_BAR;
            }
        }
        if constexpr (ALIGN_EPI) { if (wr == 0) PG8_BAR; }
        if constexpr (!Epi::AFTER_DRAIN) { E(acc, cur, wr, wc, fr, fq); S.done(cur); }
        if (!has_next) break;
#pragma unroll
        for (int a = 0; a < 2; ++a)
#pragma unroll
            for (int b = 0; b < 2; ++b)
#pragma unroll
                for (int m = 0; m < 4; ++m)
#pragma unroll
                    for (int n = 0; n < 2; ++n) acc[a][b][m][n] = (f32x4){0.f, 0.f, 0.f, 0.f};
        cur = nxt; cA = nA; cB = nB; ++ui;
        if constexpr (ALIGN_EPI) { if (wr == 1) PG8_BAR; }
    }
    PG8_WAIT_V(0);
    if constexpr (!ALIGN_EPI) { if (wr == 0) PG8_BAR; }
    PG8_BAR;
    if constexpr (Epi::AFTER_DRAIN) { E.fused(acc, cur, wr, wc, fr, fq, lds, wid, lane); S.done(cur); }
#undef PG8_SA
#undef PG8_SB
#undef PG8_STAGE
#undef PG8_LDA
#undef PG8_LDB
#undef PG8_MMA
#undef PG8_WAIT_V
#undef PG8_WAIT_L
#undef PG8_BAR
#undef PG8_SCHED
}
}
#define GAS __attribute__((address_space(1)))
#define LAS __attribute__((address_space(3)))
typedef unsigned short bf16;
typedef unsigned v4u __attribute__((ext_vector_type(4)));
typedef float f32x4 __attribute__((ext_vector_type(4)));
typedef short bf16x8 __attribute__((ext_vector_type(8)));
typedef GAS unsigned gu32;
typedef GAS unsigned long long gu64;
#define RLX_AGENT __ATOMIC_RELAXED, __HIP_MEMORY_SCOPE_AGENT
#define LDS_WAIT() asm volatile("s_waitcnt lgkmcnt(0)" ::: "memory")
#define VM_WAIT() asm volatile("s_waitcnt vmcnt(0)" ::: "memory")
__device__ __forceinline__ unsigned long long rt() { return __builtin_amdgcn_s_memrealtime(); }
__device__ __forceinline__ unsigned f2bf(float f) { unsigned u = __builtin_bit_cast(unsigned, f); return (u + 0x7fffu + ((u >> 16) & 1u)) >> 16; }
__device__ __forceinline__ unsigned pk2(float lo, float hi) { return f2bf(lo) | (f2bf(hi) << 16); }

#define XB_TMO      128
#define XB_XCNT(j)  (256  + 64 * (j))
#define XB_XSUB(j)  (1280 + 64 * (j))
#define XB_XGEN(j)  (2304 + 64 * (j))
#define XB_TOP      3328
#define XB_TOPGEN   3392
#define XCD_BAR_WORDS 3456
#define XB_SPIN_CAP (1u << 18)

__device__ __forceinline__ unsigned xb_ld(unsigned* p)              { return __hip_atomic_load(p, __ATOMIC_RELAXED, __HIP_MEMORY_SCOPE_AGENT); }
__device__ __forceinline__ unsigned xb_add(unsigned* p, unsigned v) { return __hip_atomic_fetch_add(p, v, __ATOMIC_RELAXED, __HIP_MEMORY_SCOPE_AGENT); }
__device__ __forceinline__ unsigned xb_xcc_id() { return (unsigned)__builtin_amdgcn_s_getreg((3 << 11) | 20) & 0xFu; }
#define XB_SPIN(cond, bar) do { unsigned _sp = 0; while (cond) { __builtin_amdgcn_s_sleep(1); \
    if ((++_sp & 255u) == 0u) { if (xb_ld(&(bar)[XB_TMO])) break; if (_sp > XB_SPIN_CAP) { atomicAdd(&(bar)[XB_TMO], 1u); break; } } } } while (0)

struct XcdBarrier {
    unsigned* bar; unsigned x;
    volatile LAS unsigned* st;
};

__device__ __forceinline__ XcdBarrier xcd_barrier_post(unsigned* bar, volatile LAS unsigned* st) {
    XcdBarrier b; b.bar = bar; b.x = xb_xcc_id(); b.st = st;
    if (threadIdx.x == 0) (void)xb_add(&bar[XB_XCNT(b.x)], 1u);
    return b;
}
__device__ __forceinline__ void xcd_barrier_complete(unsigned* bar, unsigned x, unsigned& nloc, unsigned& nx) {
    const unsigned G = gridDim.x * gridDim.y * gridDim.z;
    unsigned sum, cnt, mine, sp = 0u;
    for (;;) {
        sum = 0u; cnt = 0u; mine = 0u;
#pragma unroll
        for (unsigned j = 0; j < 16; ++j) { const unsigned c = xb_ld(&bar[XB_XCNT(j)]); sum += c; cnt += (c > 0u) ? 1u : 0u; mine = (j == x) ? c : mine; }
        if (sum == G) break;
        __builtin_amdgcn_s_sleep(1);
        if ((++sp & 255u) == 0u) { if (xb_ld(&bar[XB_TMO])) break; if (sp > XB_SPIN_CAP) { atomicAdd(&bar[XB_TMO], 1u); break; } }
    }
    nloc = mine > 0u ? mine : 1u; nx = cnt > 0u ? cnt : 1u;
}

__device__ __forceinline__ void xcd_barrier(const XcdBarrier& b) {
    asm volatile("s_waitcnt vmcnt(0)" ::: "memory");
    __syncthreads();
    if (threadIdx.x == 0) {
        unsigned* bar = b.bar;
        __builtin_amdgcn_s_waitcnt(0);
        unsigned nloc = b.st[0], nx = b.st[1];
        if (nloc == 0u) { xcd_barrier_complete(bar, b.x, nloc, nx); b.st[0] = nloc; b.st[1] = nx; }
        const unsigned old = xb_add(&bar[XB_XSUB(b.x)], 1u);
        const unsigned gen = old / nloc;
        if (old + 1u == (gen + 1u) * nloc) {
            __builtin_amdgcn_fence(__ATOMIC_RELEASE, "agent");
            asm volatile("s_waitcnt vmcnt(0)" ::: "memory");
            const unsigned og = xb_add(&bar[XB_TOP], 1u);
            const unsigned tg = og / nx;
            if (og + 1u == (tg + 1u) * nx) xb_add(&bar[XB_TOPGEN], 1u);
            else XB_SPIN(xb_ld(&bar[XB_TOPGEN]) == tg, bar);
            __builtin_amdgcn_fence(__ATOMIC_ACQUIRE, "agent");
            xb_add(&bar[XB_XGEN(b.x)], 1u);
            asm volatile("s_waitcnt vmcnt(0)" ::: "memory");
        } else {
            XB_SPIN(xb_ld(&bar[XB_XGEN(b.x)]) == gen, bar);
            __builtin_amdgcn_fence(__ATOMIC_ACQUIRE, "agent");
            asm volatile("s_waitcnt vmcnt(0)" ::: "memory");
        }
    }
    __syncthreads();
}

constexpr int NWAVES = 8;
constexpr int BATCH = 4, SEQ = 4096, D = 1024, T = BATCH * SEQ, DFF = 2816, NMEM = 256, INW = 6656;
constexpr float LOG2E = 1.4426950408889634f;
constexpr float C2_SWA = 0.125f * LOG2E;
constexpr float C2_MEM = 0.0625f * LOG2E;

constexpr size_t MiB = 1u << 20;
constexpr size_t WS_CTL = 0, CTL_ZERO_BYTES = 1 * MiB;
constexpr size_t WS_SS = 1 * MiB;
constexpr size_t SS_BYTES = (size_t)T * 4 * 4;
constexpr size_t WS_MEMN = 3 * MiB, WS_MEMKV = 5 * MiB;
constexpr size_t WS_WGU1 = 9 * MiB, WS_WD1 = WS_WGU1 + (size_t)2 * DFF * D * 2, WS_WIN = WS_WD1 + (size_t)D * DFF * 2, WS_WOUT = WS_WIN + (size_t)INW * D * 2,
                 WS_WQ = WS_WOUT + 2 * MiB, WS_WKV = WS_WQ + 2 * MiB, WS_WO = WS_WKV + 4 * MiB, WS_WGU2 = WS_WO + 2 * MiB, WS_WD2 = WS_WGU2 + (size_t)2 * DFF * D * 2, WS_WEND = WS_WD2 + (size_t)D * DFF * 2;
constexpr size_t WS_B0 = 66 * MiB, WS_B1 = 98 * MiB, WS_B2 = 130 * MiB, WS_B3 = 162 * MiB, WS_B4 = 194 * MiB, WS_B5 = 226 * MiB, WS_END = 242 * MiB;
static_assert(WS_WEND <= WS_B0, "weights fit below the activation blocks");
static_assert(WS_B1 + (size_t)T * DFF * 2 <= WS_B4, "h fits in blocks 1-3");
constexpr int CW_BAR = 4096;

constexpr int RING_OFF = 0, RING_BYTES = 143360;
constexpr int LDSCTL_OFF = RING_BYTES, MISC_OFF = LDSCTL_OFF + 320;
constexpr int LDS_BYTES = 147456;
static_assert(MISC_OFF + 128 <= LDS_BYTES, "LDS map");

typedef float f32x16 __attribute__((ext_vector_type(16)));
typedef short s16x4 __attribute__((ext_vector_type(4)));
typedef int i32x4 __attribute__((ext_vector_type(4)));
typedef unsigned u32x2 __attribute__((ext_vector_type(2)));
__device__ __forceinline__ float wave_sum(float v) {
#pragma unroll
    for (int o = 1; o < 64; o <<= 1) v += __shfl_xor(v, o);
    return v;
}
__device__ __forceinline__ void glds16(const void* g, LAS unsigned char* l) { __builtin_amdgcn_global_load_lds((const unsigned*)g, (LAS unsigned*)l, 16, 0, 0); }
__device__ __forceinline__ s16x4 vtr(const LAS unsigned char* p) { typedef short v4i16_t __attribute__((ext_vector_type(4))); return __builtin_bit_cast(s16x4, __builtin_amdgcn_ds_read_tr16_b64_v4i16((LAS v4i16_t*)p)); }
__device__ __forceinline__ unsigned cvtpk(float lo, float hi) { return pg8::cvt_pk_bf16(lo, hi); }
__device__ __forceinline__ float bf_lo(unsigned w) { return __uint_as_float(w << 16); }
__device__ __forceinline__ float bf_hi(unsigned w) { return __uint_as_float(w & 0xffff0000u); }
#define MFMA32(a, b, c) __builtin_amdgcn_mfma_f32_32x32x16_bf16((a), (b), (c), 0, 0, 0)

struct Params {
    const float *x, *mem; const int* pos; const float *rel_bias, *ffn1_norm, *ffn1_wgu, *ffn1_wd, *mix_norm, *w_in, *sinks, *conv_w, *w_out, *xattn_norm, *mem_norm, *wq, *wkv, *wo, *ffn2_norm, *ffn2_wgu, *ffn2_wd, *final_norm;
    float* out; unsigned char* ws;
};

__device__ __forceinline__ int map_gu(int j) { const int pn = j >> 8, i = j & 255; return (i < 128) ? pn * 128 + i : DFF + pn * 128 + (i - 128); }
__device__ __forceinline__ int map_in(int j) {
    if (j < 1536) return j;
    if (j < 3584) { const int jj = j - 1536, p = jj >> 8, i = jj & 255; return (i < 128) ? 1536 + p * 128 + i : 3584 + p * 128 + (i - 128); }
    if (j < 5632) { const int jj = j - 3584, p = jj >> 8, i = jj & 255; return (i < 128) ? 2560 + p * 128 + i : 5632 + p * 128 + (i - 128); }
    return 4608 + (j - 5632);
}
__device__ __forceinline__ void p0_transpose_item(const float* W, int N, const float* gain, bf16* WT, int K, int out_row0, int src_col0, int k0, LAS float* scr, int lane) {
#pragma unroll 8
    for (int i = 0; i < 32; ++i) { const int kk = 2 * i + (lane >> 5); float v = W[(size_t)(k0 + kk) * N + src_col0 + (lane & 31)]; if (gain) v *= gain[k0 + kk]; scr[kk * 33 + (lane & 31)] = v; }
    LDS_WAIT(); asm volatile("" ::: "memory");
    const int c = lane & 7;
#pragma unroll
    for (int j = 0; j < 4; ++j) { const int n = (lane >> 3) + 8 * j; const LAS float* s = scr + (8 * c) * 33 + n;
        v4u o; o.x = pk2(s[0 * 33], s[1 * 33]); o.y = pk2(s[2 * 33], s[3 * 33]); o.z = pk2(s[4 * 33], s[5 * 33]); o.w = pk2(s[6 * 33], s[7 * 33]);
        *(GAS v4u*)(WT + (size_t)(out_row0 + n) * K + k0 + 8 * c) = o; }
    LDS_WAIT(); asm volatile("" ::: "memory");
}
__device__ __forceinline__ void p0_prologue(const Params& p, LAS unsigned char* lds, int wave, int lane, int vcu, int G) {
    unsigned char* ws = p.ws;
    LAS float* scr = (LAS float*)(lds + RING_OFF + wave * 16384);
    const int gw = vcu * NWAVES + wave, NGW = G * NWAVES;
    constexpr int I_GU = (D / 64) * (2 * DFF / 32), I_D = (DFF / 64) * (D / 32), I_IN = (D / 64) * (INW / 32), I_SQ = (D / 64) * (D / 32), I_KV = (D / 64) * (2 * D / 32);
    constexpr int NITEMS = 2 * I_GU + 2 * I_D + I_IN + 3 * I_SQ + I_KV;
    for (int it = gw; it < NITEMS; it += NGW) {
        int r = it; const float* W; const float* gain = nullptr; bf16* WT; int K = D, N; int mode = 0;
        if (r < I_GU) { W = p.ffn1_wgu; gain = p.ffn1_norm; WT = (bf16*)(ws + WS_WGU1); N = 2 * DFF; mode = 1; }
        else if ((r -= I_GU) < I_GU) { W = p.ffn2_wgu; gain = p.ffn2_norm; WT = (bf16*)(ws + WS_WGU2); N = 2 * DFF; mode = 1; }
        else if ((r -= I_GU) < I_IN) { W = p.w_in; gain = p.mix_norm; WT = (bf16*)(ws + WS_WIN); N = INW; mode = 2; }
        else if ((r -= I_IN) < I_D) { W = p.ffn1_wd; WT = (bf16*)(ws + WS_WD1); K = DFF; N = D; }
        else if ((r -= I_D) < I_D) { W = p.ffn2_wd; WT = (bf16*)(ws + WS_WD2); K = DFF; N = D; }
        else if ((r -= I_D) < I_KV) { W = p.wkv; WT = (bf16*)(ws + WS_WKV); N = 2 * D; }
        else if ((r -= I_KV) < I_SQ) { W = p.w_out; WT = (bf16*)(ws + WS_WOUT); N = D; }
        else if ((r -= I_SQ) < I_SQ) { W = p.wq; gain = p.xattn_norm; WT = (bf16*)(ws + WS_WQ); N = D; }
        else { r -= I_SQ; W = p.wo; WT = (bf16*)(ws + WS_WO); N = D; }
        const int nblk = N / 32, kb = r / nblk, nb = r % nblk, orow = nb * 32;
        const int scol = mode == 1 ? map_gu(orow) : mode == 2 ? map_in(orow) : orow;
        p0_transpose_item(W, N, gain, WT, K, orow, scol, kb * 64, scr, lane);
    }
    bf16* XB = (bf16*)(ws + WS_B0); float* ss0 = (float*)(ws + WS_SS);
    for (int m = gw; m < T; m += NGW) {
        const GAS f32x4* xr = (const GAS f32x4*)(p.x + (size_t)m * D) + lane; f32x4 v[4]; float s = 0.f;
#pragma unroll
        for (int j = 0; j < 4; ++j) { v[j] = xr[64 * j]; s += (v[j].x * v[j].x + v[j].y * v[j].y) + (v[j].z * v[j].z + v[j].w * v[j].w); }
        s = wave_sum(s);
        GAS unsigned long long* o8 = (GAS unsigned long long*)(XB + (size_t)m * D) + lane;
#pragma unroll
        for (int j = 0; j < 4; ++j) o8[64 * j] = (unsigned long long)pk2(v[j].x, v[j].y) | ((unsigned long long)pk2(v[j].z, v[j].w) << 32);
        if (lane == 0) *(GAS f32x4*)(ss0 + (size_t)m * 4) = (f32x4){s, 0.f, 0.f, 0.f};
    }
    bf16* MEMN = (bf16*)(ws + WS_MEMN);
    for (int m = gw; m < BATCH * NMEM; m += NGW) {
        const GAS f32x4* xr = (const GAS f32x4*)(p.mem + (size_t)m * D) + lane; const GAS f32x4* gr = (const GAS f32x4*)p.mem_norm + lane; f32x4 v[4]; float s = 0.f;
#pragma unroll
        for (int j = 0; j < 4; ++j) { v[j] = xr[64 * j]; s += (v[j].x * v[j].x + v[j].y * v[j].y) + (v[j].z * v[j].z + v[j].w * v[j].w); }
        const float r = 1.0f / sqrtf(wave_sum(s) * (1.0f / D) + 1e-6f);
        GAS unsigned long long* o8 = (GAS unsigned long long*)(MEMN + (size_t)m * D) + lane;
#pragma unroll
        for (int j = 0; j < 4; ++j) { const f32x4 g = gr[64 * j]; o8[64 * j] = (unsigned long long)pk2(v[j].x * r * g.x, v[j].y * r * g.y) | ((unsigned long long)pk2(v[j].z * r * g.z, v[j].w * r * g.w) << 32); }
    }
}

namespace swa {
constexpr int LK = 0, LV = 32768, LPQ = 65536, LPK = LPQ + 512, LLUT = LPK + 1024, LUTP = 136, LST = 69632, STP = 68, STB = 32 * STP * 4;
static_assert(LLUT + 4 * LUTP * 4 <= LST && LST + NWAVES * STB <= RING_BYTES, "swa LDS map");
struct Tensors { const bf16 *Q, *K, *V, *CU, *GB, *SA; bf16* MG; const int* pos; const float *rel_bias, *sinks, *conv_w; };
__device__ __forceinline__ void unit(LAS unsigned char* lds, const Tensors& A, int b, int n, int kvh) {
    int tid_ = threadIdx.x; asm volatile("" : "+v"(tid_));
    const int tid = tid_, lane = tid & 63, r32 = lane & 31, hi = lane >> 5, wid = __builtin_amdgcn_readfirstlane(tid >> 6), g = wid >> 1, hb = wid & 1;
    const int rowbase = b * SEQ, q0 = n * 128, k0 = q0 - 128;
#pragma unroll
    for (int t = 0; t < 4; ++t) { const int kr = k0 + 64 * t, krc = kr < 0 ? kr + 128 : kr;
        glds16(A.K + (size_t)(rowbase + krc + lane) * 256 + kvh * 64 + wid * 8, lds + LK + t * 8192 + wid * 1024);
        glds16(A.V + (size_t)(rowbase + krc + 16 * (wid & 3) + (lane >> 2)) * 256 + kvh * 64 + (wid >> 2) * 32 + (lane & 3) * 8, lds + LV + t * 8192 + wid * 1024); }
    LAS int* pq = (LAS int*)(lds + LPQ); LAS int* pk = (LAS int*)(lds + LPK); LAS float* lut = (LAS float*)(lds + LLUT);
    if (tid < 128) pq[tid] = A.pos[rowbase + q0 + tid];
    else if (tid < 384) { const int kk = tid - 128, kr = k0 + kk; pk[kk] = kr < 0 ? (1 << 30) : A.pos[rowbase + kr]; }
    for (int e = tid; e < 4 * 129; e += NWAVES * 64) { const int gg = e / 129, idx = e % 129; float v;
        if (idx == 128) v = -1e30f;
        else { int bucket = idx; if (idx >= 16) { int large = 16 + (int)(logf((float)idx / 16.0f) / 2.0794415416798357f * 16.0f); bucket = large < 31 ? large : 31; }
            v = A.rel_bias[bucket * 16 + kvh * 4 + gg] * LOG2E; }
        lut[gg * LUTP + idx] = v; }
    asm volatile("s_waitcnt vmcnt(0) lgkmcnt(0)" ::: "memory"); __syncthreads();
    const int head = kvh * 4 + g; const float sink2 = A.sinks[head] * LOG2E;
    const LAS float* lutg = lut + g * LUTP;
    LAS float* st = (LAS float*)(lds + LST + wid * STB);
    const LAS unsigned char* vp0 = lds + LV + ((lane >> 4) & 1) * 32 + (lane & 3) * 8 + (4 * hi + ((lane & 15) >> 2)) * 64;
    const int ch = lane & 7, ccol = head * 64 + ch * 8;
    f32x4 cw[3][2];
#pragma unroll
    for (int j = 0; j < 3; ++j) { cw[j][0] = *(const f32x4*)(A.conv_w + j * D + ccol); cw[j][1] = *(const f32x4*)(A.conv_w + j * D + ccol + 4); }
    for (int sub = 0; sub < 2; ++sub) {
        const int qi = hb * 64 + sub * 32 + r32; const size_t qrow = (size_t)rowbase + q0 + qi;
        bf16x8 qr[4];
#pragma unroll
        for (int d0 = 0; d0 < 4; ++d0) qr[d0] = *(const bf16x8*)(A.Q + qrow * D + head * 64 + d0 * 16 + hi * 8);
        const int pqv = pq[qi];
        f32x16 p[8];
#pragma unroll
        for (int blk = 0; blk < 8; ++blk) { const LAS unsigned char* kb = lds + LK + (blk >> 1) * 8192 + hi * 1024 + ((blk & 1) * 32 + r32) * 16; f32x16 a = {};
#pragma unroll
            for (int d0 = 0; d0 < 4; ++d0) a = MFMA32(*(const LAS bf16x8*)(kb + d0 * 2048), qr[d0], a);
            p[blk] = a; }
        float mx = sink2;
#pragma unroll
        for (int blk = 0; blk < 8; ++blk)
#pragma unroll
            for (int a = 0; a < 4; ++a) { const i32x4 pk4 = *(const LAS i32x4*)(pk + 32 * blk + 8 * a + 4 * hi);
#pragma unroll
                for (int j = 0; j < 4; ++j) { const unsigned rel = (unsigned)(pqv - pk4[j]); const unsigned idx = rel < 128u ? rel : 128u; const float s = p[blk][4 * a + j] + lutg[idx]; p[blk][4 * a + j] = s; mx = fmaxf(mx, s); } }
        mx = fmaxf(mx, __shfl_xor(mx, 32));
        float l = 0.f;
#pragma unroll
        for (int blk = 0; blk < 8; ++blk)
#pragma unroll
            for (int r = 0; r < 16; ++r) { const float e = __builtin_amdgcn_exp2f(p[blk][r] - mx); p[blk][r] = e; l += e; }
        l += __shfl_xor(l, 32); l += __builtin_amdgcn_exp2f(sink2 - mx);
        const float inv = 1.0f / l;
        f32x16 o[2]; o[0] = (f32x16){}; o[1] = (f32x16){};
#pragma unroll
        for (int blk = 0; blk < 8; ++blk)
#pragma unroll
            for (int s = 0; s < 2; ++s) { v4u pw; pw.x = cvtpk(p[blk][8 * s + 0], p[blk][8 * s + 1]); pw.y = cvtpk(p[blk][8 * s + 2], p[blk][8 * s + 3]); pw.z = cvtpk(p[blk][8 * s + 4], p[blk][8 * s + 5]); pw.w = cvtpk(p[blk][8 * s + 6], p[blk][8 * s + 7]);
                const bf16x8 pa = __builtin_bit_cast(bf16x8, pw); const int ks = (blk & 1) * 2 + s;
#pragma unroll
                for (int dh = 0; dh < 2; ++dh) { const LAS unsigned char* vp = vp0 + (blk >> 1) * 8192 + dh * 4096 + ks * 1024; const s16x4 lo = vtr(vp), hi4 = vtr(vp + 512);
                    const bf16x8 vf = (bf16x8){lo[0], lo[1], lo[2], lo[3], hi4[0], hi4[1], hi4[2], hi4[3]};
                    o[dh] = MFMA32(vf, pa, o[dh]); } }
#pragma unroll
        for (int dh = 0; dh < 2; ++dh)
#pragma unroll
            for (int a = 0; a < 4; ++a) *(LAS f32x4*)(st + r32 * STP + 32 * dh + 8 * a + 4 * hi) = (f32x4){o[dh][4 * a] * inv, o[dh][4 * a + 1] * inv, o[dh][4 * a + 2] * inv, o[dh][4 * a + 3] * inv};
        asm volatile("s_waitcnt lgkmcnt(0)" ::: "memory");
#pragma unroll
        for (int i = 0; i < 4; ++i) { const int row = i * 8 + (lane >> 3), tin = q0 + hb * 64 + sub * 32 + row; const size_t off = ((size_t)rowbase + tin) * D + ccol;
            const f32x4 o0 = *(const LAS f32x4*)(st + row * STP + ch * 8), o1 = *(const LAS f32x4*)(st + row * STP + ch * 8 + 4);
            const v4u sa = *(const v4u*)(A.SA + off), gb = *(const v4u*)(A.GB + off), c0 = *(const v4u*)(A.CU + off);
            v4u c1 = (v4u){0u, 0u, 0u, 0u}, c2 = (v4u){0u, 0u, 0u, 0u};
            if (tin >= 1) c1 = *(const v4u*)(A.CU + off - D);
            if (tin >= 2) c2 = *(const v4u*)(A.CU + off - 2 * D);
            float ov[8] = {o0[0], o0[1], o0[2], o0[3], o1[0], o1[1], o1[2], o1[3]}; float res[8];
#pragma unroll
            for (int j = 0; j < 4; ++j) {
                const float w0a = cw[0][j >> 1][(2 * j) & 3], w0b = cw[0][j >> 1][(2 * j + 1) & 3], w1a = cw[1][j >> 1][(2 * j) & 3], w1b = cw[1][j >> 1][(2 * j + 1) & 3], w2a = cw[2][j >> 1][(2 * j) & 3], w2b = cw[2][j >> 1][(2 * j + 1) & 3];
                const float cva = w0a * bf_lo(c2[j]) + w1a * bf_lo(c1[j]) + w2a * bf_lo(c0[j]), cvb = w0b * bf_hi(c2[j]) + w1b * bf_hi(c1[j]) + w2b * bf_hi(c0[j]);
                res[2 * j] = bf_lo(sa[j]) * ov[2 * j] + bf_lo(gb[j]) * cva; res[2 * j + 1] = bf_hi(sa[j]) * ov[2 * j + 1] + bf_hi(gb[j]) * cvb; }
            v4u w; w.x = cvtpk(res[0], res[1]); w.y = cvtpk(res[2], res[3]); w.z = cvtpk(res[4], res[5]); w.w = cvtpk(res[6], res[7]);
            *(v4u*)(A.MG + off) = w; }
        asm volatile("s_waitcnt lgkmcnt(0)" ::: "memory");
    }
    __syncthreads();
}
}

namespace xat {
struct Tensors { const bf16 *XQ, *KV; bf16* O; };
__device__ __forceinline__ void unit(LAS unsigned char* lds, const Tensors& A, int pm, int h) {
    int tid_ = threadIdx.x; asm volatile("" : "+v"(tid_));
    const int tid = tid_, lane = tid & 63, r32 = lane & 31, hi = lane >> 5, wid = __builtin_amdgcn_readfirstlane(tid >> 6);
    const int b = pm >> 4; const size_t qrow = (size_t)pm * 256 + wid * 32 + r32;
    const bf16* Kb = A.KV + (size_t)(b * NMEM) * 2048 + h * 256; const bf16* Vb = Kb + 1024;
#pragma unroll
    for (int t = 0; t < 4; ++t)
#pragma unroll
        for (int c4 = 0; c4 < 4; ++c4) { const int chunk = wid * 4 + c4; glds16(Kb + (size_t)(t * 64 + lane) * 2048 + chunk * 8, lds + t * 32768 + chunk * 1024); }
    bf16x8 qr[16];
#pragma unroll
    for (int d0 = 0; d0 < 16; ++d0) qr[d0] = *(const bf16x8*)(A.XQ + qrow * D + h * 256 + d0 * 16 + hi * 8);
    asm volatile("s_waitcnt vmcnt(0)" ::: "memory"); __syncthreads();
    f32x16 p[8];
#pragma unroll
    for (int blk = 0; blk < 8; ++blk) { const LAS unsigned char* kb = lds + (blk >> 1) * 32768 + hi * 1024 + ((blk & 1) * 32 + r32) * 16; f32x16 a = {};
#pragma unroll
        for (int d0 = 0; d0 < 16; ++d0) a = MFMA32(*(const LAS bf16x8*)(kb + d0 * 2048), qr[d0], a);
        p[blk] = a; }
    asm volatile("s_waitcnt lgkmcnt(0)" ::: "memory"); __syncthreads();
#pragma unroll
    for (int t = 0; t < 4; ++t)
#pragma unroll
        for (int ks = 0; ks < 4; ++ks) glds16(Vb + (size_t)(t * 64 + 16 * ks + (lane >> 2)) * 2048 + wid * 32 + (lane & 3) * 8, lds + t * 32768 + (wid * 4 + ks) * 1024);
    float mx = -3.0e38f;
#pragma unroll
    for (int blk = 0; blk < 8; ++blk)
#pragma unroll
        for (int r = 0; r < 16; ++r) mx = fmaxf(mx, p[blk][r]);
    mx = fmaxf(mx, __shfl_xor(mx, 32));
    float l = 0.f;
#pragma unroll
    for (int blk = 0; blk < 8; ++blk)
#pragma unroll
        for (int r = 0; r < 16; ++r) { const float e = __builtin_amdgcn_exp2f(p[blk][r] - mx); p[blk][r] = e; l += e; }
    l += __shfl_xor(l, 32);
    const float inv = 1.0f / l;
    bf16x8 pa[8][2];
#pragma unroll
    for (int blk = 0; blk < 8; ++blk)
#pragma unroll
        for (int s = 0; s < 2; ++s) { v4u pw; pw.x = cvtpk(p[blk][8 * s + 0], p[blk][8 * s + 1]); pw.y = cvtpk(p[blk][8 * s + 2], p[blk][8 * s + 3]); pw.z = cvtpk(p[blk][8 * s + 4], p[blk][8 * s + 5]); pw.w = cvtpk(p[blk][8 * s + 6], p[blk][8 * s + 7]);
            pa[blk][s] = __builtin_bit_cast(bf16x8, pw); }
    asm volatile("s_waitcnt vmcnt(0)" ::: "memory"); __syncthreads();
    const LAS unsigned char* vp0 = lds + ((lane >> 4) & 1) * 32 + (lane & 3) * 8 + (4 * hi + ((lane & 15) >> 2)) * 64;
    bf16* orow = A.O + qrow * D + h * 256 + 4 * hi;
#pragma unroll
    for (int db = 0; db < 8; ++db) { f32x16 o = {};
#pragma unroll
        for (int blk = 0; blk < 8; ++blk)
#pragma unroll
            for (int s = 0; s < 2; ++s) { const LAS unsigned char* vp = vp0 + (blk >> 1) * 32768 + db * 4096 + ((blk & 1) * 2 + s) * 1024; const s16x4 lo = vtr(vp), hi4 = vtr(vp + 512);
                const bf16x8 vf = (bf16x8){lo[0], lo[1], lo[2], lo[3], hi4[0], hi4[1], hi4[2], hi4[3]};
                o = MFMA32(vf, pa[blk][s], o); }
#pragma unroll
        for (int a = 0; a < 4; ++a) { u32x2 w; w.x = cvtpk(o[4 * a] * inv, o[4 * a + 1] * inv); w.y = cvtpk(o[4 * a + 2] * inv, o[4 * a + 3] * inv); *(u32x2*)(orow + 32 * db + 8 * a) = w; } }
    asm volatile("s_waitcnt lgkmcnt(0)" ::: "memory"); __syncthreads();
}
}

__global__ void __launch_bounds__(NWAVES * 64, 2) fwd_megakernel(Params p) {
    extern __shared__ __attribute__((aligned(16))) unsigned char lds_raw[];
    LAS unsigned char* lds = (LAS unsigned char*)lds_raw;
    volatile LAS unsigned* MISC = (volatile LAS unsigned*)(lds + MISC_OFF);
    const int tid = threadIdx.x, lane = tid & 63, wave = __builtin_amdgcn_readfirstlane(tid >> 6);
    const int G = gridDim.x, bx = blockIdx.x, vcu = (G % 8 == 0) ? (bx % 8) * (G / 8) + bx / 8 : bx;
    unsigned char* ws = p.ws;
    gu32* ctl = (gu32*)(ws + WS_CTL);
    for (int u = tid; u < (LDS_BYTES - LDSCTL_OFF) / 4; u += NWAVES * 64) ((LAS unsigned*)(lds + LDSCTL_OFF))[u] = 0u;
    __syncthreads();
    XcdBarrier bar = xcd_barrier_post((unsigned*)(ctl + CW_BAR), MISC + 8);
#define GRID_BAR() xcd_barrier(bar)
    bf16* const B0 = (bf16*)(ws + WS_B0); bf16* const B1 = (bf16*)(ws + WS_B1); bf16* const B2 = (bf16*)(ws + WS_B2); bf16* const B3 = (bf16*)(ws + WS_B3); bf16* const B4 = (bf16*)(ws + WS_B4); bf16* const B5 = (bf16*)(ws + WS_B5);
    float* const ss0 = (float*)(ws + WS_SS); float* const ss1 = ss0 + (size_t)T * 4; float* const ss2 = ss1 + (size_t)T * 4; float* const ss3 = ss2 + (size_t)T * 4; float* const ss4 = ss3 + (size_t)T * 4;
    bf16* const MEMN = (bf16*)(ws + WS_MEMN); bf16* const MEMKV = (bf16*)(ws + WS_MEMKV);

    p0_prologue(p, lds, wave, lane, vcu, G);
    GRID_BAR();

    { pg8::Gemm g{MEMN, (const bf16*)(ws + WS_WKV), BATCH * NMEM, 2 * D, D}; pg8::StaticOrder S; S.init(BATCH * NMEM, 2 * D, G, (bx + 128) % G);
      pg8::EpiRowBf16 E{MEMKV, 2 * D, nullptr, 1.0f};
      pg8::gemm_phase<pg8::EpiRowBf16, pg8::StaticOrder, true, true>(lds + RING_OFF, g, S, E); }
    { pg8::Gemm g{B0, (const bf16*)(ws + WS_WGU1), T, 2 * DFF, D}; pg8::StaticOrder S; S.init(T, 2 * DFF, G, bx);
      pg8::EpiSwiglu E{B1, DFF, ss0};
      pg8::gemm_phase<pg8::EpiSwiglu, pg8::StaticOrder, true, true>(lds + RING_OFF, g, S, E); }
    GRID_BAR();
    { pg8::Gemm g{B1, (const bf16*)(ws + WS_WD1), T, D, DFF}; pg8::StaticOrder S; S.init(T, D, G, bx);
      pg8::EpiRes E{p.x, p.out, B0, ss1, 0.5f};
      pg8::gemm_phase<pg8::EpiRes, pg8::StaticOrder, false, true>(lds + RING_OFF, g, S, E); }
    GRID_BAR();
    { pg8::Gemm g{B0, (const bf16*)(ws + WS_WIN), T, INW, D}; pg8::StaticOrder S; S.init(T, INW, G, bx);
      pg8::EpiIn E{B1, B5, B5 + (size_t)T * 256, B2, B3, B4, ss1, C2_SWA};
      pg8::gemm_phase<pg8::EpiIn, pg8::StaticOrder, true, true>(lds + RING_OFF, g, S, E); }
    GRID_BAR();
    { const swa::Tensors A{B1, B5, B5 + (size_t)T * 256, B2, B3, B4, B0, p.pos, p.rel_bias, p.sinks, p.conv_w};
      for (int u = bx; u < BATCH * 32 * 4; u += G) swa::unit(lds, A, u >> 7, (u >> 2) & 31, u & 3); }
    GRID_BAR();
    { pg8::Gemm g{B0, (const bf16*)(ws + WS_WOUT), T, D, D}; pg8::StaticOrder S; S.init(T, D, G, bx);
      pg8::EpiRes E{p.out, p.out, B1, ss2, 1.0f};
      pg8::gemm_phase<pg8::EpiRes, pg8::StaticOrder, false, true>(lds + RING_OFF, g, S, E); }
    GRID_BAR();
    { pg8::Gemm g{B1, (const bf16*)(ws + WS_WQ), T, D, D}; pg8::StaticOrder S; S.init(T, D, G, bx);
      pg8::EpiRowBf16 E{B2, D, ss2, C2_MEM};
      pg8::gemm_phase<pg8::EpiRowBf16, pg8::StaticOrder, true, true>(lds + RING_OFF, g, S, E); }
    GRID_BAR();
    { const xat::Tensors A{B2, MEMKV, B3};
      for (int u = bx; u < (T / 256) * 4; u += G) xat::unit(lds, A, u >> 2, u & 3); }
    GRID_BAR();
    { pg8::Gemm g{B3, (const bf16*)(ws + WS_WO), T, D, D}; pg8::StaticOrder S; S.init(T, D, G, bx);
      pg8::EpiRes E{p.out, p.out, B0, ss3, 1.0f};
      pg8::gemm_phase<pg8::EpiRes, pg8::StaticOrder, false, true>(lds + RING_OFF, g, S, E); }
    GRID_BAR();
    { pg8::Gemm g{B0, (const bf16*)(ws + WS_WGU2), T, 2 * DFF, D}; pg8::StaticOrder S; S.init(T, 2 * DFF, G, bx);
      pg8::EpiSwiglu E{B1, DFF, ss3};
      pg8::gemm_phase<pg8::EpiSwiglu, pg8::StaticOrder, true, true>(lds + RING_OFF, g, S, E); }
    GRID_BAR();
    { pg8::Gemm g{B1, (const bf16*)(ws + WS_WD2), T, D, DFF}; pg8::StaticOrder S; S.init(T, D, G, bx);
      pg8::EpiRes E{p.out, p.out, B0, ss4, 0.5f};
      pg8::gemm_phase<pg8::EpiRes, pg8::StaticOrder, false, true>(lds + RING_OFF, g, S, E); }
    GRID_BAR();
    { const int gw = vcu * NWAVES + wave, NGW = G * NWAVES; const unsigned tmo = __hip_atomic_load((unsigned*)(ctl + CW_BAR) + XB_TMO, RLX_AGENT);
      for (int m = gw; m < T; m += NGW) { GAS f32x4* xr = (GAS f32x4*)(p.out + (size_t)m * D) + lane; const GAS f32x4* gr = (const GAS f32x4*)p.final_norm + lane; float r = pg8::row_rs(ss4, m);
          if (tmo) r = __builtin_nanf("");
#pragma unroll
          for (int j = 0; j < 4; ++j) { const f32x4 v = xr[64 * j], g = gr[64 * j]; xr[64 * j] = v * r * g; } } }
}

extern "C" void kernel_launch(void* const* d_in, const int* in_sizes, int n_in, void* d_out, int out_size, void* d_ws, size_t ws_size, hipStream_t stream) {
    static int grid = 0;
    if (grid == 0) {
        if (n_in != 21 || in_sizes[0] != T * D || out_size != T * D || ws_size < WS_END) { fprintf(stderr, "kernel_launch: unexpected shapes (n_in %d, in0 %d, out %d, ws %zu); nothing launched\n", n_in, n_in > 0 ? in_sizes[0] : -1, out_size, ws_size); grid = -1; return; }
        int dev = 0, cus = 0, per_cu = 0;
        if (hipGetDevice(&dev) != hipSuccess || hipDeviceGetAttribute(&cus, hipDeviceAttributeMultiprocessorCount, dev) != hipSuccess) { grid = -1; return; }
        if (hipFuncSetAttribute((const void*)fwd_megakernel, hipFuncAttributeMaxDynamicSharedMemorySize, LDS_BYTES) != hipSuccess) { fprintf(stderr, "kernel_launch: hipFuncSetAttribute failed\n"); grid = -1; return; }
        if (hipOccupancyMaxActiveBlocksPerMultiprocessor(&per_cu, (const void*)fwd_megakernel, NWAVES * 64, LDS_BYTES) != hipSuccess || per_cu < 1) { fprintf(stderr, "kernel_launch: occupancy query says %d blocks per CU\n", per_cu); (void)hipGetLastError(); grid = -1; return; }
        if (cus < 256) { fprintf(stderr, "kernel_launch: %d CUs < 256\n", cus); grid = -1; return; }
        grid = 256;
    }
    if (grid < 0) return;
    (void)hipMemsetAsync((char*)d_ws + WS_CTL, 0, CTL_ZERO_BYTES, stream);
    Params p{};
    p.x = (const float*)d_in[0]; p.mem = (const float*)d_in[1]; p.pos = (const int*)d_in[2]; p.rel_bias = (const float*)d_in[3]; p.ffn1_norm = (const float*)d_in[4]; p.ffn1_wgu = (const float*)d_in[5];
    p.ffn1_wd = (const float*)d_in[6]; p.mix_norm = (const float*)d_in[7]; p.w_in = (const float*)d_in[8]; p.sinks = (const float*)d_in[9]; p.conv_w = (const float*)d_in[10]; p.w_out = (const float*)d_in[11];
    p.xattn_norm = (const float*)d_in[12]; p.mem_norm = (const float*)d_in[13]; p.wq = (const float*)d_in[14]; p.wkv = (const float*)d_in[15]; p.wo = (const float*)d_in[16]; p.ffn2_norm = (const float*)d_in[17];
    p.ffn2_wgu = (const float*)d_in[18]; p.ffn2_wd = (const float*)d_in[19]; p.final_norm = (const float*)d_in[20]; p.out = (float*)d_out; p.ws = (unsigned char*)d_ws;
    hipLaunchKernelGGL(fwd_megakernel, dim3(grid), dim3(NWAVES * 64), LDS_BYTES, stream, p);
}
```

```cpp
#include <hip/hip_runtime.h>
#include <hip/hip_bf16.h>
#include <cstdio>
#include <cstdint>
#include <cmath>
namespace pg8 {
#define PG8_LAS __attribute__((address_space(3)))
typedef unsigned short bf16_t;
typedef short bf16x8 __attribute__((ext_vector_type(8)));
typedef float f32x4 __attribute__((ext_vector_type(4)));
typedef unsigned u32x4 __attribute__((ext_vector_type(4)));
constexpr int BM = 256, BK = 64, HALF = 128, HTB = HALF * BK * 2  , STAGE_BYTES = 8 * HTB, NXCD = 8, WGM = 8;

__host__ __device__ __forceinline__ int lds_byte(int r, int c) { const int st = (r >> 4) * 2 + (c >> 5), rr = r & 15, cc = c & 31, ob = rr * 64 + cc * 2; return st * 1024 + (ob ^ (((ob >> 9) & 1) << 5)); }
__host__ __device__ __forceinline__ void stage_rc(int b, int& R, int& C) { const int st = b / 1024, sb = b % 1024, swz = sb ^ (((sb >> 9) & 1) << 5); R = (st >> 1) * 16 + swz / 64; C = (st & 1) * 32 + (swz % 64) / 2; }
__host__ __device__ __forceinline__ int perm32(int rho) { const int n = rho >> 4, i = rho & 15; return 8 * (i >> 2) + 4 * n + (i & 3); }

struct Unit { int pm, pn; };
struct Gemm { const bf16_t* A; const bf16_t* Bt; int M, N, K; };

struct StaticOrder {
    int nM, nN, nwg, G, c;
    __host__ __device__ void init(int M, int N, int G_, int c_) { nM = M / BM; nN = N / BM; nwg = nM * nN; G = G_; c = c_; }
    __host__ __device__ bool next(int i, Unit& u) const {
        const long L = (long)i * G + c; if (L >= nwg) return false;
        int wgid = (int)L; { const int q = nwg / NXCD, r = nwg % NXCD, xcd = wgid % NXCD, off = wgid / NXCD; wgid = (xcd < r ? xcd * (q + 1) : r * (q + 1) + (xcd - r) * q) + off; }
        const int nig = WGM * nN, gid = wgid / nig, fm = gid * WGM, gsz = (nM - fm) < WGM ? (nM - fm) : WGM;
        u.pm = fm + ((wgid % nig) % gsz); u.pn = (wgid % nig) / gsz; return true;
    }
    __device__ __forceinline__ void a_ready(const Unit&) const {}
    __device__ __forceinline__ void done(const Unit&) const {}
};

__device__ __forceinline__ unsigned cvt_pk_bf16(float lo, float hi) { unsigned r; asm volatile("v_cvt_pk_bf16_f32 %0, %1, %2" : "=v"(r) : "v"(lo), "v"(hi)); return r; }
__device__ __forceinline__ float row_rs(const float* ss, int row) {
    const f32x4 p = *(const f32x4*)(ss + (size_t)row * 4);
    return __builtin_amdgcn_rsqf(((p[0] + p[1]) + (p[2] + p[3])) * (1.0f / 1024.0f) + 1e-6f);
}
__host__ __device__ __forceinline__ size_t blk_off(int row, int col, int kdim) { return ((size_t)(row >> 8) * (kdim >> 6) + (col >> 6)) * (BM * BK) + (size_t)(row & 255) * BK + (col & 63); }
__device__ __forceinline__ float sigmoidf_(float x) { return __builtin_amdgcn_rcpf(1.0f + __builtin_amdgcn_exp2f(-1.4426950408889634f * x)); }
__device__ __forceinline__ u32x4 pack8(const f32x4 v0, const f32x4 v1) { u32x4 w; w.x = cvt_pk_bf16(v0[0], v0[1]); w.y = cvt_pk_bf16(v0[2], v0[3]); w.z = cvt_pk_bf16(v1[0], v1[1]); w.w = cvt_pk_bf16(v1[2], v1[3]); return w; }

struct EpiRowBf16 {
    static constexpr bool PERM = true, AFTER_DRAIN = false;
    bf16_t* O; int ldc; const float* ss; float scale;
    __device__ __forceinline__ void operator()(const f32x4 (&acc)[2][2][4][2], const Unit& u, int wr, int wc, int fr, int fq) const {
        const int row0 = u.pm * BM + wr * 64 + fr, col0 = u.pn * BM + wc * 32 + 8 * fq;
#pragma unroll
        for (int ai = 0; ai < 2; ++ai)
#pragma unroll
            for (int m = 0; m < 4; ++m) { const int row = row0 + ai * HALF + m * 16; const float r = ss ? row_rs(ss, row) * scale : scale; bf16_t* rowp = O + (size_t)row * ldc + col0;
#pragma unroll
                for (int bj = 0; bj < 2; ++bj) *(u32x4*)(rowp + bj * HALF) = pack8(acc[ai][bj][m][0] * r, acc[ai][bj][m][1] * r); }
    }
};
struct EpiSwiglu {
    static constexpr bool PERM = true, AFTER_DRAIN = false;
    bf16_t* H; int ldh; const float* ss;
    __device__ __forceinline__ void operator()(const f32x4 (&acc)[2][2][4][2], const Unit& u, int wr, int wc, int fr, int fq) const {
        const int row0 = u.pm * BM + wr * 64 + fr, col0 = u.pn * HALF + wc * 32 + 8 * fq;
#pragma unroll
        for (int ai = 0; ai < 2; ++ai)
#pragma unroll
            for (int m = 0; m < 4; ++m) { const int row = row0 + ai * HALF + m * 16; const float r = row_rs(ss, row); f32x4 h[2];
#pragma unroll
                for (int n = 0; n < 2; ++n) { const f32x4 g = acc[ai][0][m][n] * r, up = acc[ai][1][m][n] * r;
#pragma unroll
                    for (int j = 0; j < 4; ++j) h[n][j] = g[j] * up[j] * sigmoidf_(g[j]); }
                *(u32x4*)(H + blk_off(row, col0, ldh)) = pack8(h[0], h[1]); }
    }
};
struct EpiIn {
    static constexpr bool PERM = true, AFTER_DRAIN = false;
    bf16_t *Q, *K, *V, *CU, *GB, *SA; const float* ss; float qscale;
    __device__ __forceinline__ void operator()(const f32x4 (&acc)[2][2][4][2], const Unit& u, int wr, int wc, int fr, int fq) const {
        const int row0 = u.pm * BM + wr * 64 + fr, cw = wc * 32 + 8 * fq, pn = u.pn;
        if (pn < 6 || pn >= 22) {
            bf16_t* base; int ldc, colt; float sc = 1.f; const bool sig = pn >= 22;
            if (pn < 4) { base = Q; ldc = 1024; colt = pn * 256; sc = qscale; } else if (pn == 4) { base = K; ldc = 256; colt = 0; } else if (pn == 5) { base = V; ldc = 256; colt = 0; } else { base = SA; ldc = 1024; colt = (pn - 22) * 256; }
#pragma unroll
            for (int ai = 0; ai < 2; ++ai)
#pragma unroll
                for (int m = 0; m < 4; ++m) { const int row = row0 + ai * HALF + m * 16; const float r = row_rs(ss, row) * sc; bf16_t* rowp = base + (size_t)row * ldc + colt + cw;
#pragma unroll
                    for (int bj = 0; bj < 2; ++bj) { f32x4 v0 = acc[ai][bj][m][0] * r, v1 = acc[ai][bj][m][1] * r;
                        if (sig) {
#pragma unroll
                            for (int j = 0; j < 4; ++j) { v0[j] = sigmoidf_(v0[j]); v1[j] = sigmoidf_(v1[j]); } }
                        *(u32x4*)(rowp + bj * HALF) = pack8(v0, v1); } }
        } else {
            const bool isgb = pn >= 14; bf16_t* base = isgb ? GB : CU; const int colt = ((pn - 6) & 7) * HALF;
#pragma unroll
            for (int ai = 0; ai < 2; ++ai)
#pragma unroll
                for (int m = 0; m < 4; ++m) { const int row = row0 + ai * HALF + m * 16; const float r = row_rs(ss, row); f32x4 h[2];
#pragma unroll
                    for (int n = 0; n < 2; ++n) { const f32x4 a = acc[ai][0][m][n] * r, b = acc[ai][1][m][n] * r;
#pragma unroll
                        for (int j = 0; j < 4; ++j) h[n][j] = a[j] * (isgb ? sigmoidf_(b[j]) : b[j]); }
                    *(u32x4*)(base + (size_t)row * 1024 + colt + cw) = pack8(h[0], h[1]); }
        }
    }
};
struct EpiRes {
    static constexpr bool PERM = true, AFTER_DRAIN = true;
    const float* base; float* out; bf16_t* xb; float* ssq; float alpha;
    __device__ __forceinline__ void fused(f32x4 (&acc)[2][2][4][2], const Unit& u, int wr, int wc, int fr, int fq, PG8_LAS unsigned char* lds, int wid, int lane) const {
        PG8_LAS float* P = (PG8_LAS float*)lds;
        const int col0 = u.pn * BM + wc * 32 + 8 * fq;
#pragma unroll
        for (int ai = 0; ai < 2; ++ai) {
            f32x4 bv[4][2][2];
#pragma unroll
            for (int m = 0; m < 4; ++m) { const size_t off = (size_t)(u.pm * BM + ai * HALF + wr * 64 + m * 16 + fr) * 1024 + col0;
#pragma unroll
                for (int bj = 0; bj < 2; ++bj) { bv[m][bj][0] = *(const f32x4*)(base + off + bj * HALF); bv[m][bj][1] = *(const f32x4*)(base + off + bj * HALF + 4); } }
#pragma unroll
            for (int m = 0; m < 4; ++m) { const int rl = ai * HALF + wr * 64 + m * 16 + fr, row = u.pm * BM + rl; const size_t off = (size_t)row * 1024 + col0; float s = 0.f;
#pragma unroll
                for (int bj = 0; bj < 2; ++bj) { const f32x4 v0 = bv[m][bj][0] + acc[ai][bj][m][0] * alpha, v1 = bv[m][bj][1] + acc[ai][bj][m][1] * alpha;
                    *(f32x4*)(out + off + bj * HALF) = v0; *(f32x4*)(out + off + bj * HALF + 4) = v1;
                    if (xb) *(u32x4*)(xb + blk_off(row, col0 + bj * HALF, 1024)) = pack8(v0, v1);
                    s += ((v0[0] * v0[0] + v0[1] * v0[1]) + (v0[2] * v0[2] + v0[3] * v0[3])) + ((v1[0] * v1[0] + v1[1] * v1[1]) + (v1[2] * v1[2] + v1[3] * v1[3])); }
                s += __shfl_xor(s, 16); s += __shfl_xor(s, 32);
                if (fq == 0) P[rl * 4 + wc] = s; }
            asm volatile("" ::: "memory"); }
        asm volatile("s_waitcnt lgkmcnt(0)" ::: "memory"); __builtin_amdgcn_s_barrier(); asm volatile("" ::: "memory");
        const int tid = wid * 64 + lane;
        if (tid < 256) { const f32x4 p = *(const PG8_LAS f32x4*)(P + tid * 4); ssq[(size_t)(u.pm * BM + tid) * 4 + u.pn] = (p[0] + p[1]) + (p[2] + p[3]); }
    }
};

template <class Epi, class Sched, bool ALIGN_EPI = false, bool SP2 = false>
__device__ __forceinline__ void gemm_phase(PG8_LAS unsigned char* lds, const Gemm g, const Sched& S, const Epi& E) {
    int tid_ = threadIdx.x; asm volatile("" : "+v"(tid_));
    const int tid = tid_, wid = __builtin_amdgcn_readfirstlane(tid >> 6), lane = tid & 63, wr = wid >> 2, wc = wid & 3, fr = lane & 15, fq = lane >> 4;
    const int K = g.K, nt = K / BK;
    unsigned voffA[2], voffB[2];
#pragma unroll
    for (int i = 0; i < 2; ++i) { int R, C; stage_rc(tid * 16 + i * 8192, R, C); const int Rb = Epi::PERM ? ((R & ~31) + perm32(R & 31)) : R;
        voffA[i] = (unsigned)(R * BK + C) * 2u; voffB[i] = (unsigned)(Rb * BK + C) * 2u; }
    const size_t kstep = (size_t)(BM * BK * 2);
    const size_t hstep = (size_t)HALF * BK * 2;
    const size_t tstep = (size_t)nt * kstep;
    const unsigned ldsw = (unsigned)wid * 1024u;
    const int aoff = lds_byte(wr * 64 + fr, fq * 8), boff = lds_byte(wc * 32 + fr, fq * 8);
#define PG8_SA(b, h) (((b) * 2 + (h)) * HTB)
#define PG8_SB(b, h) ((4 + (b) * 2 + (h)) * HTB)
#define PG8_STAGE(bufoff, gbase, voff) do { _Pragma("unroll") for (int _i = 0; _i < 2; ++_i) \
        __builtin_amdgcn_global_load_lds((const unsigned*)((const char*)(gbase) + (voff)[_i]), (PG8_LAS unsigned*)(lds + (bufoff) + ldsw + _i * 8192), 16, 0, 0); } while (0)
#define PG8_LDA(dst, b, h) do { _Pragma("unroll") for (int m = 0; m < 4; ++m) _Pragma("unroll") for (int k = 0; k < 2; ++k) dst[m][k] = *(const PG8_LAS bf16x8*)(lds + PG8_SA(b, h) + aoff + m * 2048 + k * 1024); } while (0)
#define PG8_LDB(dst, b, h) do { _Pragma("unroll") for (int n = 0; n < 2; ++n) _Pragma("unroll") for (int k = 0; k < 2; ++k) dst[n][k] = *(const PG8_LAS bf16x8*)(lds + PG8_SB(b, h) + boff + n * 2048 + k * 1024); } while (0)
#define PG8_MMA(ai, bj, At, Bt) do { __builtin_amdgcn_s_setprio(1); _Pragma("unroll") for (int m = 0; m < 4; ++m) _Pragma("unroll") for (int n = 0; n < 2; ++n) _Pragma("unroll") for (int k = 0; k < 2; ++k) \
        acc[ai][bj][m][n] = __builtin_amdgcn_mfma_f32_16x16x32_bf16(Bt[n][k], At[m][k], acc[ai][bj][m][n], 0, 0, 0); __builtin_amdgcn_s_setprio(0); } while (0)
#define PG8_WAIT_V(n) asm volatile("s_waitcnt vmcnt(" #n ")" ::: "memory")
#define PG8_WAIT_L(n) asm volatile("s_waitcnt lgkmcnt(" #n ")" ::: "memory")
#define PG8_BAR __builtin_amdgcn_s_barrier()
#define PG8_SCHED __builtin_amdgcn_sched_barrier(0)
    Unit cur, nxt; int ui = 0;
    if (!S.next(0, cur)) return;
    f32x4 acc[2][2][4][2];
#pragma unroll
    for (int a = 0; a < 2; ++a)
#pragma unroll
        for (int b = 0; b < 2; ++b)
#pragma unroll
            for (int m = 0; m < 4; ++m)
#pragma unroll
                for (int n = 0; n < 2; ++n) acc[a][b][m][n] = (f32x4){0.f, 0.f, 0.f, 0.f};
    bf16x8 At[4][2], B0[2][2], B1[2][2];
    const char* cA = (const char*)g.A + (size_t)cur.pm * tstep; const char* cB = (const char*)g.Bt + (size_t)cur.pn * tstep;
    S.a_ready(cur);
    if constexpr (SP2) {
        PG8_STAGE(PG8_SB(0, 0), cB, voffB); PG8_STAGE(PG8_SB(0, 1), cB + hstep, voffB); PG8_STAGE(PG8_SA(0, 0), cA, voffA); PG8_STAGE(PG8_SA(0, 1), cA + hstep, voffA);
        if (wr == 1) PG8_BAR;
        PG8_WAIT_V(2); PG8_BAR;
        PG8_STAGE(PG8_SB(1, 0), cB + kstep, voffB); PG8_STAGE(PG8_SA(1, 0), cA + kstep, voffA); PG8_STAGE(PG8_SB(1, 1), cB + hstep + kstep, voffB);
        PG8_WAIT_V(6); PG8_BAR;
    } else {
        PG8_STAGE(PG8_SB(0, 0), cB, voffB); PG8_STAGE(PG8_SA(0, 0), cA, voffA); PG8_STAGE(PG8_SB(0, 1), cB + hstep, voffB); PG8_STAGE(PG8_SA(0, 1), cA + hstep, voffA);
        if (wr == 1) PG8_BAR;
        PG8_WAIT_V(4); PG8_BAR;
        PG8_STAGE(PG8_SB(1, 0), cB + kstep, voffB); PG8_STAGE(PG8_SA(1, 0), cA + kstep, voffA); PG8_STAGE(PG8_SB(1, 1), cB + hstep + kstep, voffB);
        PG8_WAIT_V(6); PG8_BAR;
    }
    for (;;) {
        const bool has_next = S.next(ui + 1, nxt);
        const char* nA = has_next ? (const char*)g.A + (size_t)nxt.pm * tstep : cA; const char* nB = has_next ? (const char*)g.Bt + (size_t)nxt.pn * tstep : cB;
        for (int t = 0; t < nt; t += 2) {
            const bool last = (t == nt - 2);
            const char* a1 = cA + (size_t)(t + 1) * kstep;
            const char* a2 = last ? nA : cA + (size_t)(t + 2) * kstep; const char* b2 = last ? nB : cB + (size_t)(t + 2) * kstep;
            const char* a3 = a2 + kstep; const char* b3 = b2 + kstep;
            if (last && has_next) S.a_ready(nxt);
            if constexpr (SP2) {
            PG8_LDB(B0, 0, 0); PG8_LDB(B1, 0, 1); PG8_SCHED; PG8_LDA(At, 0, 0); PG8_STAGE(PG8_SA(1, 1), a1 + hstep, voffA);
            PG8_WAIT_V(8); PG8_WAIT_L(0); PG8_BAR; PG8_MMA(0, 0, At, B0); PG8_MMA(0, 1, At, B1); PG8_BAR; PG8_SCHED;
            PG8_LDA(At, 0, 1); PG8_STAGE(PG8_SB(0, 0), b2, voffB); PG8_STAGE(PG8_SB(0, 1), b2 + hstep, voffB); PG8_STAGE(PG8_SA(0, 0), a2, voffA);
            PG8_WAIT_V(8); PG8_WAIT_L(0); PG8_BAR; PG8_MMA(1, 0, At, B0); PG8_MMA(1, 1, At, B1); PG8_BAR; PG8_SCHED;
            PG8_LDB(B0, 1, 0); PG8_LDB(B1, 1, 1); PG8_SCHED; PG8_LDA(At, 1, 0); PG8_STAGE(PG8_SA(0, 1), a2 + hstep, voffA);
            PG8_WAIT_V(8); PG8_WAIT_L(0); PG8_BAR; PG8_MMA(0, 0, At, B0); PG8_MMA(0, 1, At, B1); PG8_BAR; PG8_SCHED;
            PG8_LDA(At, 1, 1); PG8_STAGE(PG8_SB(1, 0), b3, voffB); PG8_STAGE(PG8_SB(1, 1), b3 + hstep, voffB); PG8_STAGE(PG8_SA(1, 0), a3, voffA);
            PG8_WAIT_V(8); PG8_WAIT_L(0); PG8_BAR; PG8_MMA(1, 0, At, B0); PG8_MMA(1, 1, At, B1); PG8_BAR; PG8_SCHED;
            } else {
            PG8_LDB(B0, 0, 0); PG8_SCHED; PG8_LDA(At, 0, 0); PG8_STAGE(PG8_SA(1, 1), a1 + hstep, voffA);
            PG8_WAIT_L(8); PG8_BAR; PG8_WAIT_L(0); PG8_MMA(0, 0, At, B0); PG8_BAR; PG8_SCHED;
            PG8_LDB(B1, 0, 1); PG8_STAGE(PG8_SB(0, 0), b2, voffB);
            PG8_BAR; PG8_WAIT_L(0); PG8_MMA(0, 1, At, B1); PG8_BAR;
            PG8_LDA(At, 0, 1); PG8_STAGE(PG8_SA(0, 0), a2, voffA);
            PG8_BAR; PG8_WAIT_L(0); PG8_MMA(1, 0, At, B0); PG8_BAR; PG8_SCHED;
            PG8_STAGE(PG8_SB(0, 1), b2 + hstep, voffB);
            PG8_WAIT_V(6); PG8_BAR; PG8_MMA(1, 1, At, B1); PG8_BAR;
            PG8_LDB(B0, 1, 0); PG8_SCHED; PG8_LDA(At, 1, 0); PG8_STAGE(PG8_SA(0, 1), a2 + hstep, voffA);
            PG8_WAIT_L(8); PG8_BAR; PG8_WAIT_L(0); PG8_MMA(0, 0, At, B0); PG8_BAR; PG8_SCHED;
            PG8_LDB(B1, 1, 1); PG8_STAGE(PG8_SB(1, 0), b3, voffB);
            PG8_BAR; PG8_WAIT_L(0); PG8_MMA(0, 1, At, B1); PG8_BAR;
            PG8_LDA(At, 1, 1); PG8_STAGE(PG8_SA(1, 0), a3, voffA);
            PG8_BAR; PG8_WAIT_L(0); PG8_MMA(1, 0, At, B0); PG8_BAR; PG8_SCHED;
            PG8_STAGE(PG8_SB(1, 1), b3 + hstep, voffB);
            PG8_WAIT_V(6); PG8_BAR; PG8_MMA(1, 1, At, B1); PG8_BAR;
            }
        }
        if constexpr (ALIGN_EPI) { if (wr == 0) PG8_BAR; }
        if constexpr (!Epi::AFTER_DRAIN) { E(acc, cur, wr, wc, fr, fq); S.done(cur); }
        if (!has_next) break;
#pragma unroll
        for (int a = 0; a < 2; ++a)
#pragma unroll
            for (int b = 0; b < 2; ++b)
#pragma unroll
                for (int m = 0; m < 4; ++m)
#pragma unroll
                    for (int n = 0; n < 2; ++n) acc[a][b][m][n] = (f32x4){0.f, 0.f, 0.f, 0.f};
        cur = nxt; cA = nA; cB = nB; ++ui;
        if constexpr (ALIGN_EPI) { if (wr == 1) PG8_BAR; }
    }
    PG8_WAIT_V(0);
    if constexpr (!ALIGN_EPI) { if (wr == 0) PG8_BAR; }
    PG8_BAR;
    if constexpr (Epi::AFTER_DRAIN) { E.fused(acc, cur, wr, wc, fr, fq, lds, wid, lane); S.done(cur); }
#undef PG8_SA
#undef PG8_SB
#undef PG8_STAGE
#undef PG8_LDA
#undef PG8_LDB
#undef PG8_MMA
#undef PG8_WAIT_V
#undef PG8_WAIT_L
#undef PG8_BAR
#undef PG8_SCHED
}
}
#define GAS __attribute__((address_space(1)))
#define LAS __attribute__((address_space(3)))
typedef unsigned short bf16;
typedef unsigned v4u __attribute__((ext_vector_type(4)));
typedef float f32x4 __attribute__((ext_vector_type(4)));
typedef short bf16x8 __attribute__((ext_vector_type(8)));
typedef GAS unsigned gu32;
typedef GAS unsigned long long gu64;
#define RLX_AGENT __ATOMIC_RELAXED, __HIP_MEMORY_SCOPE_AGENT
#define LDS_WAIT() asm volatile("s_waitcnt lgkmcnt(0)" ::: "memory")
#define VM_WAIT() asm volatile("s_waitcnt vmcnt(0)" ::: "memory")
__device__ __forceinline__ unsigned long long rt() { return __builtin_amdgcn_s_memrealtime(); }
__device__ __forceinline__ unsigned f2bf(float f) { unsigned u = __builtin_bit_cast(unsigned, f); return (u + 0x7fffu + ((u >> 16) & 1u)) >> 16; }
__device__ __forceinline__ unsigned pk2(float lo, float hi) { return f2bf(lo) | (f2bf(hi) << 16); }

#define XB_TMO      128
#define XB_XCNT(j)  (256  + 64 * (j))
#define XB_XSUB(j)  (1280 + 64 * (j))
#define XB_XGEN(j)  (2304 + 64 * (j))
#define XB_TOP      3328
#define XB_TOPGEN   3392
#define XCD_BAR_WORDS 3456
#define XB_SPIN_CAP (1u << 18)

__device__ __forceinline__ unsigned xb_ld(unsigned* p)              { return __hip_atomic_load(p, __ATOMIC_RELAXED, __HIP_MEMORY_SCOPE_AGENT); }
__device__ __forceinline__ unsigned xb_add(unsigned* p, unsigned v) { return __hip_atomic_fetch_add(p, v, __ATOMIC_RELAXED, __HIP_MEMORY_SCOPE_AGENT); }
__device__ __forceinline__ unsigned xb_xcc_id() { return (unsigned)__builtin_amdgcn_s_getreg((3 << 11) | 20) & 0xFu; }
#define XB_SPIN(cond, bar) do { unsigned _sp = 0; while (cond) { __builtin_amdgcn_s_sleep(1); \
    if ((++_sp & 255u) == 0u) { if (xb_ld(&(bar)[XB_TMO])) break; if (_sp > XB_SPIN_CAP) { atomicAdd(&(bar)[XB_TMO], 1u); break; } } } } while (0)

struct XcdBarrier {
    unsigned* bar; unsigned x;
    volatile LAS unsigned* st;
};

__device__ __forceinline__ XcdBarrier xcd_barrier_post(unsigned* bar, volatile LAS unsigned* st) {
    XcdBarrier b; b.bar = bar; b.x = xb_xcc_id(); b.st = st;
    if (threadIdx.x == 0) (void)xb_add(&bar[XB_XCNT(b.x)], 1u);
    return b;
}
__device__ __forceinline__ void xcd_barrier_complete(unsigned* bar, unsigned x, unsigned& nloc, unsigned& nx) {
    const unsigned G = gridDim.x * gridDim.y * gridDim.z;
    unsigned sum, cnt, mine, sp = 0u;
    for (;;) {
        sum = 0u; cnt = 0u; mine = 0u;
#pragma unroll
        for (unsigned j = 0; j < 16; ++j) { const unsigned c = xb_ld(&bar[XB_XCNT(j)]); sum += c; cnt += (c > 0u) ? 1u : 0u; mine = (j == x) ? c : mine; }
        if (sum == G) break;
        __builtin_amdgcn_s_sleep(1);
        if ((++sp & 255u) == 0u) { if (xb_ld(&bar[XB_TMO])) break; if (sp > XB_SPIN_CAP) { atomicAdd(&bar[XB_TMO], 1u); break; } }
    }
    nloc = mine > 0u ? mine : 1u; nx = cnt > 0u ? cnt : 1u;
}

__device__ __forceinline__ void xcd_barrier(const XcdBarrier& b) {
    asm volatile("s_waitcnt vmcnt(0)" ::: "memory");
    __syncthreads();
    if (threadIdx.x == 0) {
        unsigned* bar = b.bar;
        __builtin_amdgcn_s_waitcnt(0);
        unsigned nloc = b.st[0], nx = b.st[1];
        if (nloc == 0u) { xcd_barrier_complete(bar, b.x, nloc, nx); b.st[0] = nloc; b.st[1] = nx; }
        const unsigned old = xb_add(&bar[XB_XSUB(b.x)], 1u);
        const unsigned gen = old / nloc;
        if (old + 1u == (gen + 1u) * nloc) {
            __builtin_amdgcn_fence(__ATOMIC_RELEASE, "agent");
            asm volatile("s_waitcnt vmcnt(0)" ::: "memory");
            const unsigned og = xb_add(&bar[XB_TOP], 1u);
            const unsigned tg = og / nx;
            if (og + 1u == (tg + 1u) * nx) xb_add(&bar[XB_TOPGEN], 1u);
            else XB_SPIN(xb_ld(&bar[XB_TOPGEN]) == tg, bar);
            __builtin_amdgcn_fence(__ATOMIC_ACQUIRE, "agent");
            xb_add(&bar[XB_XGEN(b.x)], 1u);
            asm volatile("s_waitcnt vmcnt(0)" ::: "memory");
        } else {
            XB_SPIN(xb_ld(&bar[XB_XGEN(b.x)]) == gen, bar);
            __builtin_amdgcn_fence(__ATOMIC_ACQUIRE, "agent");
            asm volatile("s_waitcnt vmcnt(0)" ::: "memory");
        }
    }
    __syncthreads();
}

constexpr int NWAVES = 8;
constexpr int BATCH = 4, SEQ = 4096, D = 1024, T = BATCH * SEQ, DFF = 2816, NMEM = 256, INW = 6656;
constexpr float LOG2E = 1.4426950408889634f;
constexpr float C2_SWA = 0.125f * LOG2E;
constexpr float C2_MEM = 0.0625f * LOG2E;

constexpr size_t MiB = 1u << 20;
constexpr size_t WS_CTL = 0, CTL_ZERO_BYTES = 1 * MiB;
constexpr size_t WS_SS = 1 * MiB;
constexpr size_t SS_BYTES = (size_t)T * 4 * 4;
constexpr size_t WS_MEMN = 3 * MiB, WS_MEMKV = 5 * MiB;
constexpr size_t WS_WGU1 = 9 * MiB, WS_WD1 = WS_WGU1 + (size_t)2 * DFF * D * 2, WS_WIN = WS_WD1 + (size_t)D * DFF * 2, WS_WOUT = WS_WIN + (size_t)INW * D * 2,
                 WS_WQ = WS_WOUT + 2 * MiB, WS_WKV = WS_WQ + 2 * MiB, WS_WO = WS_WKV + 4 * MiB, WS_WGU2 = WS_WO + 2 * MiB, WS_WD2 = WS_WGU2 + (size_t)2 * DFF * D * 2, WS_WEND = WS_WD2 + (size_t)D * DFF * 2;
constexpr size_t WS_B0 = 66 * MiB, WS_B1 = 98 * MiB, WS_B2 = 130 * MiB, WS_B3 = 162 * MiB, WS_B4 = 194 * MiB, WS_B5 = 226 * MiB, WS_END = 242 * MiB;
static_assert(WS_WEND <= WS_B0, "weights fit below the activation blocks");
static_assert(WS_B1 + (size_t)T * DFF * 2 <= WS_B4, "h fits in blocks 1-3");
constexpr int CW_BAR = 4096;

constexpr int RING_OFF = 0, RING_BYTES = 143360;
constexpr int LDSCTL_OFF = RING_BYTES, MISC_OFF = LDSCTL_OFF + 320;
constexpr int LDS_BYTES = 147456;
static_assert(MISC_OFF + 128 <= LDS_BYTES, "LDS map");

typedef float f32x16 __attribute__((ext_vector_type(16)));
typedef short s16x4 __attribute__((ext_vector_type(4)));
typedef int i32x4 __attribute__((ext_vector_type(4)));
typedef unsigned u32x2 __attribute__((ext_vector_type(2)));
__device__ __forceinline__ float wave_sum(float v) {
#pragma unroll
    for (int o = 1; o < 64; o <<= 1) v += __shfl_xor(v, o);
    return v;
}
__device__ __forceinline__ void glds16(const void* g, LAS unsigned char* l) { __builtin_amdgcn_global_load_lds((const unsigned*)g, (LAS unsigned*)l, 16, 0, 0); }
__device__ __forceinline__ s16x4 vtr(const LAS unsigned char* p) { typedef short v4i16_t __attribute__((ext_vector_type(4))); return __builtin_bit_cast(s16x4, __builtin_amdgcn_ds_read_tr16_b64_v4i16((LAS v4i16_t*)p)); }
__device__ __forceinline__ unsigned cvtpk(float lo, float hi) { return pg8::cvt_pk_bf16(lo, hi); }
__device__ __forceinline__ float bf_lo(unsigned w) { return __uint_as_float(w << 16); }
__device__ __forceinline__ float bf_hi(unsigned w) { return __uint_as_float(w & 0xffff0000u); }
#define MFMA32(a, b, c) __builtin_amdgcn_mfma_f32_32x32x16_bf16((a), (b), (c), 0, 0, 0)

struct Params {
    const float *x, *mem; const int* pos; const float *rel_bias, *ffn1_norm, *ffn1_wgu, *ffn1_wd, *mix_norm, *w_in, *sinks, *conv_w, *w_out, *xattn_norm, *mem_norm, *wq, *wkv, *wo, *ffn2_norm, *ffn2_wgu, *ffn2_wd, *final_norm;
    float* out; unsigned char* ws;
};

__device__ __forceinline__ int map_gu(int j) { const int pn = j >> 8, i = j & 255; return (i < 128) ? pn * 128 + i : DFF + pn * 128 + (i - 128); }
__device__ __forceinline__ int map_in(int j) {
    if (j < 1536) return j;
    if (j < 3584) { const int jj = j - 1536, p = jj >> 8, i = jj & 255; return (i < 128) ? 1536 + p * 128 + i : 3584 + p * 128 + (i - 128); }
    if (j < 5632) { const int jj = j - 3584, p = jj >> 8, i = jj & 255; return (i < 128) ? 2560 + p * 128 + i : 5632 + p * 128 + (i - 128); }
    return 4608 + (j - 5632);
}
__device__ __forceinline__ void p0_transpose_item(const float* W, int N, const float* gain, bf16* WT, int nt, int orow, int scol, int kb, LAS unsigned char* scr, int lane) {
    const int q = lane >> 4, c = lane & 15, k0 = kb * 64;
    f32x4 v[16];
    const float* src = W + (size_t)(k0 + 16 * q) * N + scol + 4 * c;
#pragma unroll
    for (int i = 0; i < 16; ++i) v[i] = *(const GAS f32x4*)(src + (size_t)i * N);
    if (gain) {
#pragma unroll
        for (int e = 0; e < 4; ++e) { const f32x4 gv = *(const GAS f32x4*)(gain + k0 + 16 * q + 4 * e);
#pragma unroll
            for (int t = 0; t < 4; ++t) v[4 * e + t] = v[4 * e + t] * gv[t]; } }
#pragma unroll
    for (int j = 0; j < 4; ++j) { LAS unsigned char* dst = scr + (4 * c + j) * 144 + 32 * q;
        v4u w0, w1;
        w0.x = cvtpk(v[0][j], v[1][j]); w0.y = cvtpk(v[2][j], v[3][j]); w0.z = cvtpk(v[4][j], v[5][j]); w0.w = cvtpk(v[6][j], v[7][j]);
        w1.x = cvtpk(v[8][j], v[9][j]); w1.y = cvtpk(v[10][j], v[11][j]); w1.z = cvtpk(v[12][j], v[13][j]); w1.w = cvtpk(v[14][j], v[15][j]);
        *(LAS v4u*)dst = w0; *(LAS v4u*)(dst + 16) = w1; }
    LDS_WAIT(); asm volatile("" ::: "memory");
    bf16* blk = WT + ((size_t)(orow >> 8) * nt + kb) * (256 * 64) + (size_t)(orow & 255) * 64;
#pragma unroll
    for (int i = 0; i < 8; ++i) { const int n = 8 * i + (lane >> 3), ch = lane & 7; *(GAS v4u*)(blk + n * 64 + ch * 8) = *(const LAS v4u*)(scr + n * 144 + ch * 16); }
    LDS_WAIT(); asm volatile("" ::: "memory");
}
__device__ __forceinline__ void p0_rows4(const float* X, int m0, bf16* XB, float* ss, const float* gain, int lane) {
    f32x4 v[4][4]; float s[4];
#pragma unroll
    for (int r = 0; r < 4; ++r)
#pragma unroll
        for (int j = 0; j < 4; ++j) v[r][j] = ((const GAS f32x4*)(X + (size_t)(m0 + r) * D) + lane)[64 * j];
#pragma unroll
    for (int r = 0; r < 4; ++r) { float a = 0.f;
#pragma unroll
        for (int j = 0; j < 4; ++j) a += (v[r][j].x * v[r][j].x + v[r][j].y * v[r][j].y) + (v[r][j].z * v[r][j].z + v[r][j].w * v[r][j].w);
        s[r] = wave_sum(a); }
#pragma unroll
    for (int r = 0; r < 4; ++r) { const int m = m0 + r; const float rs = gain ? 1.0f / sqrtf(s[r] * (1.0f / D) + 1e-6f) : 1.0f;
#pragma unroll
        for (int j = 0; j < 4; ++j) { f32x4 o = v[r][j];
            if (gain) { const f32x4 g = ((const GAS f32x4*)gain + lane)[64 * j]; o = o * rs * g; }
            u32x2 w; w.x = cvtpk(o.x, o.y); w.y = cvtpk(o.z, o.w);
            *(GAS u32x2*)(XB + pg8::blk_off(m, 4 * lane + 256 * j, D)) = w; }
        if (ss && lane == 0) *(GAS f32x4*)(ss + (size_t)m * 4) = (f32x4){s[r], 0.f, 0.f, 0.f}; }
}
__device__ __forceinline__ void p0_prologue(const Params& p, LAS unsigned char* lds, int wave, int lane, int vcu, int G) {
    unsigned char* ws = p.ws;
    LAS unsigned char* scr = lds + RING_OFF + wave * 16384;
    const int gw = vcu * NWAVES + wave, NGW = G * NWAVES;
    constexpr int I_GU = (D / 64) * (2 * DFF / 64), I_D = (DFF / 64) * (D / 64), I_IN = (D / 64) * (INW / 64), I_SQ = (D / 64) * (D / 64), I_KV = (D / 64) * (2 * D / 64);
    constexpr int NITEMS = 2 * I_GU + 2 * I_D + I_IN + 3 * I_SQ + I_KV, NXJ = T / 4, NMJ = BATCH * NMEM / 4;
    for (int it = gw; it < NITEMS + NXJ + NMJ; it += NGW) {
        int r = it;
        if (r >= NITEMS) { r -= NITEMS;
            if (r < NXJ) p0_rows4(p.x, 4 * r, (bf16*)(ws + WS_B0), (float*)(ws + WS_SS), nullptr, lane);
            else p0_rows4(p.mem, 4 * (r - NXJ), (bf16*)(ws + WS_MEMN), nullptr, p.mem_norm, lane);
            continue; }
        const float* W; const float* gain = nullptr; bf16* WT; int K = D, N; int mode = 0;
        if (r < I_GU) { W = p.ffn1_wgu; gain = p.ffn1_norm; WT = (bf16*)(ws + WS_WGU1); N = 2 * DFF; mode = 1; }
        else if ((r -= I_GU) < I_GU) { W = p.ffn2_wgu; gain = p.ffn2_norm; WT = (bf16*)(ws + WS_WGU2); N = 2 * DFF; mode = 1; }
        else if ((r -= I_GU) < I_IN) { W = p.w_in; gain = p.mix_norm; WT = (bf16*)(ws + WS_WIN); N = INW; mode = 2; }
        else if ((r -= I_IN) < I_D) { W = p.ffn1_wd; WT = (bf16*)(ws + WS_WD1); K = DFF; N = D; }
        else if ((r -= I_D) < I_D) { W = p.ffn2_wd; WT = (bf16*)(ws + WS_WD2); K = DFF; N = D; }
        else if ((r -= I_D) < I_KV) { W = p.wkv; WT = (bf16*)(ws + WS_WKV); N = 2 * D; }
        else if ((r -= I_KV) < I_SQ) { W = p.w_out; WT = (bf16*)(ws + WS_WOUT); N = D; }
        else if ((r -= I_SQ) < I_SQ) { W = p.wq; gain = p.xattn_norm; WT = (bf16*)(ws + WS_WQ); N = D; }
        else { r -= I_SQ; W = p.wo; WT = (bf16*)(ws + WS_WO); N = D; }
        const int nblk = N / 64, kb = r / nblk, nb = r % nblk, orow = nb * 64;
        const int scol = mode == 1 ? map_gu(orow) : mode == 2 ? map_in(orow) : orow;
        p0_transpose_item(W, N, gain, WT, K / 64, orow, scol, kb, scr, lane);
    }
}

namespace swa {
constexpr int LK = 0, LV = 32768, LPQ = 65536, LPK = LPQ + 512, LLUT = LPK + 1024, LUTP = 136, LST = 69632, STP = 68, STB = 32 * STP * 4;
static_assert(LLUT + 4 * LUTP * 4 <= LST && LST + NWAVES * STB <= RING_BYTES, "swa LDS map");
struct Tensors { const bf16 *Q, *K, *V, *CU, *GB, *SA; bf16* MG; const int* pos; const float *rel_bias, *sinks, *conv_w; };
__device__ __forceinline__ void unit(LAS unsigned char* lds, const Tensors& A, int b, int n, int kvh) {
    int tid_ = threadIdx.x; asm volatile("" : "+v"(tid_));
    const int tid = tid_, lane = tid & 63, r32 = lane & 31, hi = lane >> 5, wid = __builtin_amdgcn_readfirstlane(tid >> 6), g = wid >> 1, hb = wid & 1;
    const int rowbase = b * SEQ, q0 = n * 128, k0 = q0 - 128;
#pragma unroll
    for (int t = 0; t < 4; ++t) { const int kr = k0 + 64 * t, krc = kr < 0 ? kr + 128 : kr;
        glds16(A.K + (size_t)(rowbase + krc + lane) * 256 + kvh * 64 + wid * 8, lds + LK + t * 8192 + wid * 1024);
        glds16(A.V + (size_t)(rowbase + krc + 16 * (wid & 3) + (lane >> 2)) * 256 + kvh * 64 + (wid >> 2) * 32 + (lane & 3) * 8, lds + LV + t * 8192 + wid * 1024); }
    LAS int* pq = (LAS int*)(lds + LPQ); LAS int* pk = (LAS int*)(lds + LPK); LAS float* lut = (LAS float*)(lds + LLUT);
    if (tid < 128) pq[tid] = A.pos[rowbase + q0 + tid];
    else if (tid < 384) { const int kk = tid - 128, kr = k0 + kk; pk[kk] = kr < 0 ? (1 << 30) : A.pos[rowbase + kr]; }
    for (int e = tid; e < 4 * 129; e += NWAVES * 64) { const int gg = e / 129, idx = e % 129; float v;
        if (idx == 128) v = -1e30f;
        else { int bucket = idx; if (idx >= 16) { int large = 16 + (int)(logf((float)idx / 16.0f) / 2.0794415416798357f * 16.0f); bucket = large < 31 ? large : 31; }
            v = A.rel_bias[bucket * 16 + kvh * 4 + gg] * LOG2E; }
        lut[gg * LUTP + idx] = v; }
    asm volatile("s_waitcnt vmcnt(0) lgkmcnt(0)" ::: "memory"); __syncthreads();
    const int head = kvh * 4 + g; const float sink2 = A.sinks[head] * LOG2E;
    const LAS float* lutg = lut + g * LUTP;
    LAS float* st = (LAS float*)(lds + LST + wid * STB);
    const LAS unsigned char* vp0 = lds + LV + ((lane >> 4) & 1) * 32 + (lane & 3) * 8 + (4 * hi + ((lane & 15) >> 2)) * 64;
    const int ch = lane & 7, ccol = head * 64 + ch * 8;
    f32x4 cw[3][2];
#pragma unroll
    for (int j = 0; j < 3; ++j) { cw[j][0] = *(const f32x4*)(A.conv_w + j * D + ccol); cw[j][1] = *(const f32x4*)(A.conv_w + j * D + ccol + 4); }
    for (int sub = 0; sub < 2; ++sub) {
        const int qi = hb * 64 + sub * 32 + r32; const size_t qrow = (size_t)rowbase + q0 + qi;
        bf16x8 qr[4];
#pragma unroll
        for (int d0 = 0; d0 < 4; ++d0) qr[d0] = *(const bf16x8*)(A.Q + qrow * D + head * 64 + d0 * 16 + hi * 8);
        const int pqv = pq[qi];
        f32x16 p[8];
#pragma unroll
        for (int blk = 0; blk < 8; ++blk) { const LAS unsigned char* kb = lds + LK + (blk >> 1) * 8192 + hi * 1024 + ((blk & 1) * 32 + r32) * 16; f32x16 a = {};
#pragma unroll
            for (int d0 = 0; d0 < 4; ++d0) a = MFMA32(*(const LAS bf16x8*)(kb + d0 * 2048), qr[d0], a);
            p[blk] = a; }
        float mx = sink2;
#pragma unroll
        for (int blk = 0; blk < 8; ++blk)
#pragma unroll
            for (int a = 0; a < 4; ++a) { const i32x4 pk4 = *(const LAS i32x4*)(pk + 32 * blk + 8 * a + 4 * hi);
#pragma unroll
                for (int j = 0; j < 4; ++j) { const unsigned rel = (unsigned)(pqv - pk4[j]); const unsigned idx = rel < 128u ? rel : 128u; const float s = p[blk][4 * a + j] + lutg[idx]; p[blk][4 * a + j] = s; mx = fmaxf(mx, s); } }
        mx = fmaxf(mx, __shfl_xor(mx, 32));
        float l = 0.f;
#pragma unroll
        for (int blk = 0; blk < 8; ++blk)
#pragma unroll
            for (int r = 0; r < 16; ++r) { const float e = __builtin_amdgcn_exp2f(p[blk][r] - mx); p[blk][r] = e; l += e; }
        l += __shfl_xor(l, 32); l += __builtin_amdgcn_exp2f(sink2 - mx);
        const float inv = 1.0f / l;
        f32x16 o[2]; o[0] = (f32x16){}; o[1] = (f32x16){};
#pragma unroll
        for (int blk = 0; blk < 8; ++blk)
#pragma unroll
            for (int s = 0; s < 2; ++s) { v4u pw; pw.x = cvtpk(p[blk][8 * s + 0], p[blk][8 * s + 1]); pw.y = cvtpk(p[blk][8 * s + 2], p[blk][8 * s + 3]); pw.z = cvtpk(p[blk][8 * s + 4], p[blk][8 * s + 5]); pw.w = cvtpk(p[blk][8 * s + 6], p[blk][8 * s + 7]);
                const bf16x8 pa = __builtin_bit_cast(bf16x8, pw); const int ks = (blk & 1) * 2 + s;
#pragma unroll
                for (int dh = 0; dh < 2; ++dh) { const LAS unsigned char* vp = vp0 + (blk >> 1) * 8192 + dh * 4096 + ks * 1024; const s16x4 lo = vtr(vp), hi4 = vtr(vp + 512);
                    const bf16x8 vf = (bf16x8){lo[0], lo[1], lo[2], lo[3], hi4[0], hi4[1], hi4[2], hi4[3]};
                    o[dh] = MFMA32(vf, pa, o[dh]); } }
#pragma unroll
        for (int dh = 0; dh < 2; ++dh)
#pragma unroll
            for (int a = 0; a < 4; ++a) *(LAS f32x4*)(st + r32 * STP + 32 * dh + 8 * a + 4 * hi) = (f32x4){o[dh][4 * a] * inv, o[dh][4 * a + 1] * inv, o[dh][4 * a + 2] * inv, o[dh][4 * a + 3] * inv};
        asm volatile("s_waitcnt lgkmcnt(0)" ::: "memory");
#pragma unroll
        for (int i = 0; i < 4; ++i) { const int row = i * 8 + (lane >> 3), tin = q0 + hb * 64 + sub * 32 + row; const size_t off = ((size_t)rowbase + tin) * D + ccol;
            const f32x4 o0 = *(const LAS f32x4*)(st + row * STP + ch * 8), o1 = *(const LAS f32x4*)(st + row * STP + ch * 8 + 4);
            const v4u sa = *(const v4u*)(A.SA + off), gb = *(const v4u*)(A.GB + off), c0 = *(const v4u*)(A.CU + off);
            v4u c1 = (v4u){0u, 0u, 0u, 0u}, c2 = (v4u){0u, 0u, 0u, 0u};
            if (tin >= 1) c1 = *(const v4u*)(A.CU + off - D);
            if (tin >= 2) c2 = *(const v4u*)(A.CU + off - 2 * D);
            float ov[8] = {o0[0], o0[1], o0[2], o0[3], o1[0], o1[1], o1[2], o1[3]}; float res[8];
#pragma unroll
            for (int j = 0; j < 4; ++j) {
                const float w0a = cw[0][j >> 1][(2 * j) & 3], w0b = cw[0][j >> 1][(2 * j + 1) & 3], w1a = cw[1][j >> 1][(2 * j) & 3], w1b = cw[1][j >> 1][(2 * j + 1) & 3], w2a = cw[2][j >> 1][(2 * j) & 3], w2b = cw[2][j >> 1][(2 * j + 1) & 3];
                const float cva = w0a * bf_lo(c2[j]) + w1a * bf_lo(c1[j]) + w2a * bf_lo(c0[j]), cvb = w0b * bf_hi(c2[j]) + w1b * bf_hi(c1[j]) + w2b * bf_hi(c0[j]);
                res[2 * j] = bf_lo(sa[j]) * ov[2 * j] + bf_lo(gb[j]) * cva; res[2 * j + 1] = bf_hi(sa[j]) * ov[2 * j + 1] + bf_hi(gb[j]) * cvb; }
            v4u w; w.x = cvtpk(res[0], res[1]); w.y = cvtpk(res[2], res[3]); w.z = cvtpk(res[4], res[5]); w.w = cvtpk(res[6], res[7]);
            *(v4u*)(A.MG + pg8::blk_off(rowbase + tin, ccol, D)) = w; }
        asm volatile("s_waitcnt lgkmcnt(0)" ::: "memory");
    }
    __syncthreads();
}
}

namespace xat {
struct Tensors { const bf16 *XQ, *KV; bf16* O; };
__device__ __forceinline__ void unit(LAS unsigned char* lds, const Tensors& A, int pm, int h) {
    int tid_ = threadIdx.x; asm volatile("" : "+v"(tid_));
    const int tid = tid_, lane = tid & 63, r32 = lane & 31, hi = lane >> 5, wid = __builtin_amdgcn_readfirstlane(tid >> 6);
    const int b = pm >> 4; const size_t qrow = (size_t)pm * 256 + wid * 32 + r32;
    const bf16* Kb = A.KV + (size_t)(b * NMEM) * 2048 + h * 256; const bf16* Vb = Kb + 1024;
#pragma unroll
    for (int t = 0; t < 4; ++t)
#pragma unroll
        for (int c4 = 0; c4 < 4; ++c4) { const int chunk = wid * 4 + c4; glds16(Kb + (size_t)(t * 64 + lane) * 2048 + chunk * 8, lds + t * 32768 + chunk * 1024); }
    bf16x8 qr[16];
#pragma unroll
    for (int d0 = 0; d0 < 16; ++d0) qr[d0] = *(const bf16x8*)(A.XQ + qrow * D + h * 256 + d0 * 16 + hi * 8);
    asm volatile("s_waitcnt vmcnt(0)" ::: "memory"); __syncthreads();
    f32x16 p[8];
#pragma unroll
    for (int blk = 0; blk < 8; ++blk) { const LAS unsigned char* kb = lds + (blk >> 1) * 32768 + hi * 1024 + ((blk & 1) * 32 + r32) * 16; f32x16 a = {};
#pragma unroll
        for (int d0 = 0; d0 < 16; ++d0) a = MFMA32(*(const LAS bf16x8*)(kb + d0 * 2048), qr[d0], a);
        p[blk] = a; }
    asm volatile("s_waitcnt lgkmcnt(0)" ::: "memory"); __syncthreads();
#pragma unroll
    for (int t = 0; t < 4; ++t)
#pragma unroll
        for (int ks = 0; ks < 4; ++ks) glds16(Vb + (size_t)(t * 64 + 16 * ks + (lane >> 2)) * 2048 + wid * 32 + (lane & 3) * 8, lds + t * 32768 + (wid * 4 + ks) * 1024);
    float mx = -3.0e38f;
#pragma unroll
    for (int blk = 0; blk < 8; ++blk)
#pragma unroll
        for (int r = 0; r < 16; ++r) mx = fmaxf(mx, p[blk][r]);
    mx = fmaxf(mx, __shfl_xor(mx, 32));
    float l = 0.f;
#pragma unroll
    for (int blk = 0; blk < 8; ++blk)
#pragma unroll
        for (int r = 0; r < 16; ++r) { const float e = __builtin_amdgcn_exp2f(p[blk][r] - mx); p[blk][r] = e; l += e; }
    l += __shfl_xor(l, 32);
    const float inv = 1.0f / l;
    bf16x8 pa[8][2];
#pragma unroll
    for (int blk = 0; blk < 8; ++blk)
#pragma unroll
        for (int s = 0; s < 2; ++s) { v4u pw; pw.x = cvtpk(p[blk][8 * s + 0], p[blk][8 * s + 1]); pw.y = cvtpk(p[blk][8 * s + 2], p[blk][8 * s + 3]); pw.z = cvtpk(p[blk][8 * s + 4], p[blk][8 * s + 5]); pw.w = cvtpk(p[blk][8 * s + 6], p[blk][8 * s + 7]);
            pa[blk][s] = __builtin_bit_cast(bf16x8, pw); }
    asm volatile("s_waitcnt vmcnt(0)" ::: "memory"); __syncthreads();
    const LAS unsigned char* vp0 = lds + ((lane >> 4) & 1) * 32 + (lane & 3) * 8 + (4 * hi + ((lane & 15) >> 2)) * 64;
#pragma unroll
    for (int db = 0; db < 8; ++db) { f32x16 o = {};
#pragma unroll
        for (int blk = 0; blk < 8; ++blk)
#pragma unroll
            for (int s = 0; s < 2; ++s) { const LAS unsigned char* vp = vp0 + (blk >> 1) * 32768 + db * 4096 + ((blk & 1) * 2 + s) * 1024; const s16x4 lo = vtr(vp), hi4 = vtr(vp + 512);
                const bf16x8 vf = (bf16x8){lo[0], lo[1], lo[2], lo[3], hi4[0], hi4[1], hi4[2], hi4[3]};
                o = MFMA32(vf, pa[blk][s], o); }
#pragma unroll
        for (int a = 0; a < 4; ++a) { u32x2 w; w.x = cvtpk(o[4 * a] * inv, o[4 * a + 1] * inv); w.y = cvtpk(o[4 * a + 2] * inv, o[4 * a + 3] * inv); *(u32x2*)(A.O + pg8::blk_off((int)qrow, h * 256 + 32 * db + 8 * a + 4 * hi, D)) = w; } }
    asm volatile("s_waitcnt lgkmcnt(0)" ::: "memory"); __syncthreads();
}
}

__global__ void __launch_bounds__(NWAVES * 64, 2) fwd_megakernel(Params p) {
    extern __shared__ __attribute__((aligned(16))) unsigned char lds_raw[];
    LAS unsigned char* lds = (LAS unsigned char*)lds_raw;
    volatile LAS unsigned* MISC = (volatile LAS unsigned*)(lds + MISC_OFF);
    const int tid = threadIdx.x, lane = tid & 63, wave = __builtin_amdgcn_readfirstlane(tid >> 6);
    const int G = gridDim.x, bx = blockIdx.x, vcu = (G % 8 == 0) ? (bx % 8) * (G / 8) + bx / 8 : bx;
    unsigned char* ws = p.ws;
    gu32* ctl = (gu32*)(ws + WS_CTL);
    for (int u = tid; u < (LDS_BYTES - LDSCTL_OFF) / 4; u += NWAVES * 64) ((LAS unsigned*)(lds + LDSCTL_OFF))[u] = 0u;
    __syncthreads();
    XcdBarrier bar = xcd_barrier_post((unsigned*)(ctl + CW_BAR), MISC + 8);
#define GRID_BAR() xcd_barrier(bar)
    bf16* const B0 = (bf16*)(ws + WS_B0); bf16* const B1 = (bf16*)(ws + WS_B1); bf16* const B2 = (bf16*)(ws + WS_B2); bf16* const B3 = (bf16*)(ws + WS_B3); bf16* const B4 = (bf16*)(ws + WS_B4); bf16* const B5 = (bf16*)(ws + WS_B5);
    float* const ss0 = (float*)(ws + WS_SS); float* const ss1 = ss0 + (size_t)T * 4; float* const ss2 = ss1 + (size_t)T * 4; float* const ss3 = ss2 + (size_t)T * 4; float* const ss4 = ss3 + (size_t)T * 4;
    bf16* const MEMN = (bf16*)(ws + WS_MEMN); bf16* const MEMKV = (bf16*)(ws + WS_MEMKV);

    p0_prologue(p, lds, wave, lane, vcu, G);
    GRID_BAR();

    { pg8::Gemm g{MEMN, (const bf16*)(ws + WS_WKV), BATCH * NMEM, 2 * D, D}; pg8::StaticOrder S; S.init(BATCH * NMEM, 2 * D, G, (bx + 128) % G);
      pg8::EpiRowBf16 E{MEMKV, 2 * D, nullptr, 1.0f};
      pg8::gemm_phase<pg8::EpiRowBf16, pg8::StaticOrder, true, true>(lds + RING_OFF, g, S, E); }
    { pg8::Gemm g{B0, (const bf16*)(ws + WS_WGU1), T, 2 * DFF, D}; pg8::StaticOrder S; S.init(T, 2 * DFF, G, bx);
      pg8::EpiSwiglu E{B1, DFF, ss0};
      pg8::gemm_phase<pg8::EpiSwiglu, pg8::StaticOrder, true, true>(lds + RING_OFF, g, S, E); }
    GRID_BAR();
    { pg8::Gemm g{B1, (const bf16*)(ws + WS_WD1), T, D, DFF}; pg8::StaticOrder S; S.init(T, D, G, bx);
      pg8::EpiRes E{p.x, p.out, B0, ss1, 0.5f};
      pg8::gemm_phase<pg8::EpiRes, pg8::StaticOrder, false, true>(lds + RING_OFF, g, S, E); }
    GRID_BAR();
    { pg8::Gemm g{B0, (const bf16*)(ws + WS_WIN), T, INW, D}; pg8::StaticOrder S; S.init(T, INW, G, bx);
      pg8::EpiIn E{B1, B5, B5 + (size_t)T * 256, B2, B3, B4, ss1, C2_SWA};
      pg8::gemm_phase<pg8::EpiIn, pg8::StaticOrder, true, true>(lds + RING_OFF, g, S, E); }
    GRID_BAR();
    { const swa::Tensors A{B1, B5, B5 + (size_t)T * 256, B2, B3, B4, B0, p.pos, p.rel_bias, p.sinks, p.conv_w};
      for (int u = bx; u < BATCH * 32 * 4; u += G) swa::unit(lds, A, u >> 7, (u >> 2) & 31, u & 3); }
    GRID_BAR();
    { pg8::Gemm g{B0, (const bf16*)(ws + WS_WOUT), T, D, D}; pg8::StaticOrder S; S.init(T, D, G, bx);
      pg8::EpiRes E{p.out, p.out, B1, ss2, 1.0f};
      pg8::gemm_phase<pg8::EpiRes, pg8::StaticOrder, false, true>(lds + RING_OFF, g, S, E); }
    GRID_BAR();
    { pg8::Gemm g{B1, (const bf16*)(ws + WS_WQ), T, D, D}; pg8::StaticOrder S; S.init(T, D, G, bx);
      pg8::EpiRowBf16 E{B2, D, ss2, C2_MEM};
      pg8::gemm_phase<pg8::EpiRowBf16, pg8::StaticOrder, true, true>(lds + RING_OFF, g, S, E); }
    GRID_BAR();
    { const xat::Tensors A{B2, MEMKV, B3};
      for (int u = bx; u < (T / 256) * 4; u += G) xat::unit(lds, A, u >> 2, u & 3); }
    GRID_BAR();
    { pg8::Gemm g{B3, (const bf16*)(ws + WS_WO), T, D, D}; pg8::StaticOrder S; S.init(T, D, G, bx);
      pg8::EpiRes E{p.out, p.out, B0, ss3, 1.0f};
      pg8::gemm_phase<pg8::EpiRes, pg8::StaticOrder, false, true>(lds + RING_OFF, g, S, E); }
    GRID_BAR();
    { pg8::Gemm g{B0, (const bf16*)(ws + WS_WGU2), T, 2 * DFF, D}; pg8::StaticOrder S; S.init(T, 2 * DFF, G, bx);
      pg8::EpiSwiglu E{B1, DFF, ss3};
      pg8::gemm_phase<pg8::EpiSwiglu, pg8::StaticOrder, true, true>(lds + RING_OFF, g, S, E); }
    GRID_BAR();
    { pg8::Gemm g{B1, (const bf16*)(ws + WS_WD2), T, D, DFF}; pg8::StaticOrder S; S.init(T, D, G, bx);
      pg8::EpiRes E{p.out, p.out, nullptr, ss4, 0.5f};
      pg8::gemm_phase<pg8::EpiRes, pg8::StaticOrder, false, true>(lds + RING_OFF, g, S, E); }
    GRID_BAR();
    { const int gw = vcu * NWAVES + wave, NGW = G * NWAVES; const unsigned tmo = __hip_atomic_load((unsigned*)(ctl + CW_BAR) + XB_TMO, RLX_AGENT);
      for (int m = gw; m < T; m += NGW) { GAS f32x4* xr = (GAS f32x4*)(p.out + (size_t)m * D) + lane; const GAS f32x4* gr = (const GAS f32x4*)p.final_norm + lane; float r = pg8::row_rs(ss4, m);
          if (tmo) r = __builtin_nanf("");
#pragma unroll
          for (int j = 0; j < 4; ++j) { const f32x4 v = xr[64 * j], g = gr[64 * j]; xr[64 * j] = v * r * g; } } }
}

extern "C" void kernel_launch(void* const* d_in, const int* in_sizes, int n_in, void* d_out, int out_size, void* d_ws, size_t ws_size, hipStream_t stream) {
    static int grid = 0;
    if (grid == 0) {
        if (n_in != 21 || in_sizes[0] != T * D || out_size != T * D || ws_size < WS_END) { fprintf(stderr, "kernel_launch: unexpected shapes (n_in %d, in0 %d, out %d, ws %zu); nothing launched\n", n_in, n_in > 0 ? in_sizes[0] : -1, out_size, ws_size); grid = -1; return; }
        int dev = 0, cus = 0, per_cu = 0;
        if (hipGetDevice(&dev) != hipSuccess || hipDeviceGetAttribute(&cus, hipDeviceAttributeMultiprocessorCount, dev) != hipSuccess) { grid = -1; return; }
        if (hipFuncSetAttribute((const void*)fwd_megakernel, hipFuncAttributeMaxDynamicSharedMemorySize, LDS_BYTES) != hipSuccess) { fprintf(stderr, "kernel_launch: hipFuncSetAttribute failed\n"); grid = -1; return; }
        if (hipOccupancyMaxActiveBlocksPerMultiprocessor(&per_cu, (const void*)fwd_megakernel, NWAVES * 64, LDS_BYTES) != hipSuccess || per_cu < 1) { fprintf(stderr, "kernel_launch: occupancy query says %d blocks per CU\n", per_cu); (void)hipGetLastError(); grid = -1; return; }
        if (cus < 256) { fprintf(stderr, "kernel_launch: %d CUs < 256\n", cus); grid = -1; return; }
        grid = 256;
    }
    if (grid < 0) return;
    (void)hipMemsetAsync((char*)d_ws + WS_CTL, 0, CTL_ZERO_BYTES, stream);
    Params p{};
    p.x = (const float*)d_in[0]; p.mem = (const float*)d_in[1]; p.pos = (const int*)d_in[2]; p.rel_bias = (const float*)d_in[3]; p.ffn1_norm = (const float*)d_in[4]; p.ffn1_wgu = (const float*)d_in[5];
    p.ffn1_wd = (const float*)d_in[6]; p.mix_norm = (const float*)d_in[7]; p.w_in = (const float*)d_in[8]; p.sinks = (const float*)d_in[9]; p.conv_w = (const float*)d_in[10]; p.w_out = (const float*)d_in[11];
    p.xattn_norm = (const float*)d_in[12]; p.mem_norm = (const float*)d_in[13]; p.wq = (const float*)d_in[14]; p.wkv = (const float*)d_in[15]; p.wo = (const float*)d_in[16]; p.ffn2_norm = (const float*)d_in[17];
    p.ffn2_wgu = (const float*)d_in[18]; p.ffn2_wd = (const float*)d_in[19]; p.final_norm = (const float*)d_in[20]; p.out = (float*)d_out; p.ws = (unsigned char*)d_ws;
    hipLaunchKernelGGL(fwd_megakernel, dim3(grid), dim3(NWAVES * 64), LDS_BYTES, stream, p);
}
```
